# Optimizing an MI355X kernel written in HIP

```python
import jax, jax.numpy as jnp
from jax import lax
import numpy as np

D_MODEL = 2048
BATCH = 4
SEQ = 2048
DEPTH = 1
DEC_BATCH = 128
DEC_SEQ = 4
PAST_LEN = 16384
PAGE_SIZE = 128

MIX_WIDTH = D_MODEL
W_A = MIX_WIDTH // 2
W_B = MIX_WIDTH - W_A
CHUNK = 128
H_A = 8
DA = W_A // H_A
HEAD_B = 64
H_B = W_B // HEAD_B
LORA_W = 64
LORA_A = 64
LORA_G = 160
W_RWKV_IN = 3 * W_B + LORA_W + LORA_A + LORA_G
W_IN = 2 * W_A + W_RWKV_IN
N_KEYS = 128
N_EXPERTS = N_KEYS * N_KEYS
PEER_HEADS = 8
D_KEY = 256
HALF_KEY = D_KEY // 2
TOPK = 16
TOK_BLOCK = 128
RMS_EPS = 1e-6
LN_EPS = 1e-5
GN_EPS = 6.4e-4

kernel_name = 'hymba_gmlp_rwkv7_peer_step'


def rms_norm(x, g):
    xf = x.astype(jnp.float32)
    y = xf * lax.rsqrt(jnp.mean(xf * xf, axis=-1, keepdims=True) + RMS_EPS)
    return (y * g.astype(jnp.float32)).astype(x.dtype)


def layer_norm(x, g, b, eps):
    xf = x.astype(jnp.float32)
    mu = jnp.mean(xf, axis=-1, keepdims=True)
    xc = xf - mu
    var = jnp.mean(xc * xc, axis=-1, keepdims=True)
    return xc * lax.rsqrt(var + eps) * g.astype(jnp.float32) + b.astype(jnp.float32)


def chunk_spatial_gate(z, ln_g, ln_b, ws, bs):
    bn, t_len, _ = z.shape
    u, v = z[..., :W_A], z[..., W_A:]
    v = layer_norm(v, ln_g, ln_b, LN_EPS).astype(z.dtype)
    n_chunks = -(-t_len // CHUNK)
    pad = n_chunks * CHUNK - t_len
    vp = jnp.pad(v, ((0, 0), (0, pad), (0, 0))).reshape(bn, n_chunks, CHUNK, H_A, DA)
    mask = jnp.tril(jnp.ones((CHUNK, CHUNK), dtype=bool))
    ws_c = jnp.where(mask[None], ws, 0)
    mixed = jnp.einsum('hts,bcshd->bcthd', ws_c, vp) + bs.T[None, None, :, :, None]
    mixed = mixed.reshape(bn, n_chunks * CHUNK, W_A)[:, :t_len]
    start = ((t_len - 1) // CHUNK) * CHUNK
    return u * mixed, v[:, start:]


def rwkv7_mix(p, p_prev_row, s0, mu, w0, w_up, a0, a_up, g_up, k_k, k_a, r_k, gn_g, gn_b):
    f32 = jnp.float32
    bn, t_len, _ = p.shape
    pf = p.astype(f32)
    p_prev = jnp.concatenate([p_prev_row.astype(f32)[:, None], pf[:, :-1]], axis=1)
    q = pf + (p_prev - pf) * mu.astype(f32)
    r = q[..., :W_B]
    k = q[..., W_B:2 * W_B]
    v = q[..., 2 * W_B:3 * W_B]
    o = 3 * W_B
    xw = q[..., o:o + LORA_W]
    xa = q[..., o + LORA_W:o + LORA_W + LORA_A]
    xg = q[..., o + LORA_W + LORA_A:]
    w = -jax.nn.softplus(-(w0.astype(f32) + jnp.tanh(xw) @ w_up.astype(f32))) - 0.5
    decay = jnp.exp(-jnp.exp(w))
    a = jax.nn.sigmoid(a0.astype(f32) + xa @ a_up.astype(f32))
    g = jax.nn.sigmoid(xg) @ g_up.astype(f32)
    hs = (bn, t_len, H_B, HEAD_B)
    kk = (k * k_k.astype(f32)).reshape(hs)
    kk = kk * lax.rsqrt(jnp.maximum(jnp.sum(kk * kk, axis=-1, keepdims=True), 1e-24))
    k = k * (1.0 + (a - 1.0) * k_a.astype(f32))
    r_h, k_h, v_h = r.reshape(hs), k.reshape(hs), v.reshape(hs)
    a_h, d_h = a.reshape(hs), decay.reshape(hs)

    def step(state, inp):
        r_t, w_t, k_t, v_t, a_t, b_t = inp
        sa = jnp.einsum('bhij,bhj->bhi', state, a_t)
        state = (state * w_t[:, :, None, :] + sa[..., None] * b_t[:, :, None, :]
                 + v_t[..., None] * k_t[:, :, None, :])
        y_t = jnp.einsum('bhij,bhj->bhi', state, r_t)
        return state, y_t

    xs = tuple(jnp.moveaxis(t, 1, 0) for t in (r_h, d_h, k_h, v_h, -kk, kk * a_h))
    s_final, ys = lax.scan(step, s0.astype(f32), xs)
    y = jnp.moveaxis(ys, 0, 1)
    y = layer_norm(y, gn_g.reshape(H_B, HEAD_B), gn_b.reshape(H_B, HEAD_B), GN_EPS)
    bonus = jnp.sum(r_h * k_h * r_k.astype(f32), axis=-1, keepdims=True) * v_h
    out = (y + bonus).reshape(bn, t_len, W_B) * g
    return out.astype(p.dtype), s_final


def peer_ffn(xn, w_q, sub_keys, u_tab, v_tab):
    f32 = jnp.float32
    bn, t_len, d = xn.shape
    n_tok = bn * t_len
    xt = xn.reshape(n_tok, d)
    q = (xt @ w_q).reshape(n_tok, PEER_HEADS, 2, HALF_KEY).astype(f32)
    s = jnp.einsum('nhcd,ckd->nhck', q, sub_keys.astype(f32))
    top_s, top_i = lax.top_k(s, TOPK)
    cand_s = top_s[..., 0, :, None] + top_s[..., 1, None, :]
    cand_i = top_i[..., 0, :, None] * N_KEYS + top_i[..., 1, None, :]
    best_s, best_j = lax.top_k(cand_s.reshape(n_tok, PEER_HEADS, TOPK * TOPK), TOPK)
    experts = jnp.take_along_axis(cand_i.reshape(n_tok, PEER_HEADS, TOPK * TOPK), best_j, axis=-1)
    gates = jax.nn.softmax(best_s, axis=-1)
    n_blk = -(-n_tok // TOK_BLOCK)
    pad = n_blk * TOK_BLOCK - n_tok
    xb = jnp.pad(xt, ((0, pad), (0, 0))).reshape(n_blk, TOK_BLOCK, d)
    eb = jnp.pad(experts, ((0, pad), (0, 0), (0, 0))).reshape(n_blk, TOK_BLOCK, PEER_HEADS, TOPK)
    gb = jnp.pad(gates, ((0, pad), (0, 0), (0, 0))).reshape(n_blk, TOK_BLOCK, PEER_HEADS, TOPK)

    def block(args):
        x_b, e_b, g_b = args
        ue = u_tab[e_b]
        act = jax.nn.gelu(jnp.einsum('nhkd,nd->nhk', ue, x_b).astype(f32), approximate=False)
        coef = (g_b * act).astype(x_b.dtype)
        return jnp.einsum('nhk,nhkd->nd', coef, v_tab[e_b])

    out = lax.map(block, (xb, eb, gb)).reshape(n_blk * TOK_BLOCK, d)[:n_tok]
    return out.reshape(bn, t_len, d)


def _layer(x, shift_row, s0, norm1_g, w_in, ln_v_g, ln_v_b, ws, bs, mu, w0, w_up, a0, a_up,
           g_up, k_k, k_a, r_k, gn_g, gn_b, w_out, norm2_g, w_q, sub_keys, u_tab, v_tab):
    xn = rms_norm(x, norm1_g)
    proj = xn @ w_in
    z_a = jax.nn.gelu(proj[..., :2 * W_A], approximate=False)
    p_b = proj[..., 2 * W_A:]
    prev_row = shift_row.astype(xn.dtype) @ w_in[:, 2 * W_A:]
    y_a, v_rows = chunk_spatial_gate(z_a, ln_v_g, ln_v_b, ws, bs)
    y_b, s_new = rwkv7_mix(p_b, prev_row, s0, mu, w0, w_up, a0, a_up, g_up, k_k, k_a, r_k, gn_g, gn_b)
    h = x + jnp.concatenate([y_a, y_b], axis=-1) @ w_out
    y = h + peer_ffn(rms_norm(h, norm2_g), w_q, sub_keys, u_tab, v_tab)
    return y, s_new, xn[:, -1], v_rows


def setup_inputs(seed: int = 0) -> dict:
    key = jax.random.key(seed)
    ks = jax.random.split(key, 28)
    f32 = jnp.float32

    def nrm(k, shape, s):
        return s * jax.random.normal(k, shape, f32)

    L = DEPTH
    return {
        'x_prompt': nrm(ks[0], (BATCH, SEQ, D_MODEL), 1.0),
        'x_sample': nrm(ks[1], (DEC_BATCH, DEC_SEQ, D_MODEL), 1.0),
        'state_wkv': nrm(ks[2], (L, DEC_BATCH, H_B, HEAD_B, HEAD_B), 0.3),
        'state_shift': nrm(ks[3], (L, DEC_BATCH, D_MODEL), 1.0),
        'norm1_g': 1.0 + nrm(ks[4], (L, D_MODEL), 0.02),
        'w_in': nrm(ks[5], (L, D_MODEL, W_IN), D_MODEL ** -0.5),
        'ln_v_g': 1.0 + nrm(ks[6], (L, W_A), 0.02),
        'ln_v_b': nrm(ks[7], (L, W_A), 0.02),
        'ws': nrm(ks[8], (L, H_A, CHUNK, CHUNK), 0.5 * CHUNK ** -0.5),
        'bs': 1.0 + nrm(ks[9], (L, H_A, CHUNK), 0.1),
        'mu': jax.random.uniform(ks[10], (L, W_RWKV_IN), f32),
        'w0': -1.0 + nrm(ks[11], (L, W_B), 0.5),
        'w_up': nrm(ks[12], (L, LORA_W, W_B), 0.1),
        'a0': nrm(ks[13], (L, W_B), 0.1),
        'a_up': nrm(ks[14], (L, LORA_A, W_B), 0.1),
        'g_up': nrm(ks[15], (L, LORA_G, W_B), LORA_G ** -0.5),
        'k_k': 0.85 + nrm(ks[16], (L, W_B), 0.05),
        'k_a': 1.0 + nrm(ks[17], (L, W_B), 0.05),
        'r_k': nrm(ks[18], (L, H_B, HEAD_B), 0.1),
        'gn_g': 1.0 + nrm(ks[19], (L, W_B), 0.02),
        'gn_b': nrm(ks[20], (L, W_B), 0.02),
        'w_out': nrm(ks[21], (L, W_A + W_B, D_MODEL), (W_A + W_B) ** -0.5),
        'norm2_g': 1.0 + nrm(ks[22], (L, D_MODEL), 0.02),
        'w_q': nrm(ks[23], (L, D_MODEL, PEER_HEADS * D_KEY), D_MODEL ** -0.5),
        'sub_keys': nrm(ks[24], (L, 2, N_KEYS, HALF_KEY), HALF_KEY ** -0.5),
        'u_tab': nrm(ks[25], (L, N_EXPERTS, D_MODEL), D_MODEL ** -0.5),
        'v_tab': nrm(ks[26], (L, N_EXPERTS, D_MODEL), 0.1),
        'final_g': 1.0 + nrm(ks[27], (D_MODEL,), 0.02),
    }


def reference(x_prompt, x_sample, state_wkv, state_shift, norm1_g, w_in, ln_v_g, ln_v_b, ws, bs,
              mu, w0, w_up, a0, a_up, g_up, k_k, k_a, r_k, gn_g, gn_b, w_out, norm2_g, w_q,
              sub_keys, u_tab, v_tab, final_g):
    bp = x_prompt.shape[0]
    shift0 = jnp.zeros((bp, D_MODEL), x_prompt.dtype)
    wkv0 = jnp.zeros((bp, H_B, HEAD_B, HEAD_B), jnp.float32)
    yp, ys = x_prompt, x_sample
    p_wkv, p_shift, p_chunk, s_wkv, s_shift, s_chunk = [], [], [], [], [], []
    for l in range(DEPTH):
        lw = [w[l] for w in (norm1_g, w_in, ln_v_g, ln_v_b, ws, bs, mu, w0, w_up, a0, a_up, g_up,
                             k_k, k_a, r_k, gn_g, gn_b, w_out, norm2_g, w_q, sub_keys, u_tab, v_tab)]
        yp, wkv_p, sh_p, cv_p = _layer(yp, shift0, wkv0, *lw)
        ys, wkv_s, sh_s, cv_s = _layer(ys, state_shift[l], state_wkv[l], *lw)
        p_wkv.append(wkv_p); p_shift.append(sh_p); p_chunk.append(cv_p)
        s_wkv.append(wkv_s); s_shift.append(sh_s); s_chunk.append(cv_s)
    y_prompt = rms_norm(yp, final_g)
    y_sample = rms_norm(ys, final_g)
    return (y_prompt, y_sample, jnp.stack(p_wkv), jnp.stack(p_shift), jnp.stack(p_chunk),
            jnp.stack(s_wkv), jnp.stack(s_shift), jnp.stack(s_chunk))
```

```cpp
#include <hip/hip_runtime.h>
#include <hip/hip_cooperative_groups.h>
#include <cstdio>
namespace cg = cooperative_groups;

#ifndef ONE_LAUNCH
#define ONE_LAUNCH 1
#endif

typedef unsigned short bf16_t;
typedef short bf16x8 __attribute__((ext_vector_type(8)));
typedef float f32x2 __attribute__((ext_vector_type(2)));
typedef float f32x4 __attribute__((ext_vector_type(4)));
typedef float f32x16 __attribute__((ext_vector_type(16)));
typedef __bf16 bf2_t __attribute__((ext_vector_type(2)));
typedef int i32x8 __attribute__((ext_vector_type(8)));
typedef unsigned u32x4 __attribute__((ext_vector_type(4)));

constexpr int NTHR = 512;
constexpr int DM = 2048, NTOK = 8704, NPROMPT = 8192, NROW1 = 8832, WINP = 5632, WBW = 3360;
constexpr int N_PHASES = 9;

constexpr size_t O_Y = 0, O_WKVP = 17825792, O_SHP = 18087936, O_CVP = 18096128, O_WKVS = 18620416, O_SHS = 27009024, O_CVS = 27271168;
constexpr size_t OFF_UB = 0, OFF_VB = 67108864, OFF_WOUT = 134217728, OFF_WQ = 142606336, OFF_SK = 150994944, OFF_PB = 151060480,
                 OFF_ZA = 269762560, OFF_A1 = 305414144, OFF_WIN = 341590016, OFF_DEC = 364658688, OFF_AA = OFF_DEC + 35651584, OFF_GG = OFF_AA + 35651584,
                 OFF_YRAW = OFF_GG + 35651584, OFF_BONV = OFF_YRAW + 33554432, OFF_BAR = OFF_BONV + 16777216, WS_END = OFF_BAR + 16384;
constexpr size_t OFF_SU = OFF_UB + 33554432, OFF_SV = OFF_VB + 33554432, OFF_XQ = OFF_UB + 41943040, OFF_SX = OFF_UB + 60817408, OFF_WL = OFF_UB + 62914560;
constexpr size_t OFF_VN = OFF_A1, OFF_A2 = OFF_A1 + 17825792, OFF_H = OFF_PB, OFF_A3 = OFF_PB + 71303168, OFF_QB = OFF_ZA, OFF_EIDX = OFF_DEC, OFF_GATE = OFF_DEC + 4456448;

struct P { const float* in[28]; float* out; unsigned char* ws; };

enum { I_XP = 0, I_XS, I_SWKV, I_SSH, I_N1G, I_WIN, I_LNG, I_LNB, I_WS, I_BS, I_MU, I_W0, I_WUP, I_A0, I_AUP, I_GUP, I_KK, I_KA, I_RK, I_GNG, I_GNB, I_WOUT, I_N2G, I_WQ, I_SUBK, I_UT, I_VT, I_FG };

constexpr int LDS_BYTES = 153600;

__device__ __forceinline__ unsigned pk_bf16(float lo, float hi) { const f32x2 v = {lo, hi}; const bf2_t r = __builtin_convertvector(v, bf2_t); return __builtin_bit_cast(unsigned, r); }
__device__ __forceinline__ float bf_lo(unsigned u) { return __uint_as_float(u << 16); }
__device__ __forceinline__ float bf_hi(unsigned u) { return __uint_as_float(u & 0xffff0000u); }
__device__ __forceinline__ float bf1(bf16_t b) { return __uint_as_float(((unsigned)b) << 16); }
template <int C> __device__ __forceinline__ float dppf(float v) { return __int_as_float(__builtin_amdgcn_update_dpp(0, __float_as_int(v), C, 0xf, 0xf, true)); }
__device__ __forceinline__ float sum8(float v) { v += dppf<0xB1>(v); v += dppf<0x4E>(v); v += dppf<0x141>(v); return v; }
__device__ __forceinline__ float sum16(float v) { v = sum8(v); v += dppf<0x140>(v); return v; }
__device__ __forceinline__ float rdlane(float v, int l) { return __int_as_float(__builtin_amdgcn_readlane(__float_as_int(v), l)); }
__device__ __forceinline__ float sum64(float v) { v = sum16(v); return (rdlane(v, 0) + rdlane(v, 16)) + (rdlane(v, 32) + rdlane(v, 48)); }
template <int C> __device__ __forceinline__ unsigned dppu(unsigned v) { return (unsigned)__builtin_amdgcn_update_dpp(0, (int)v, C, 0xf, 0xf, true); }
__device__ __forceinline__ unsigned umax64(unsigned v) {
    unsigned t;
    t = dppu<0xB1>(v); v = t > v ? t : v;
    t = dppu<0x4E>(v); v = t > v ? t : v;
    t = dppu<0x141>(v); v = t > v ? t : v;
    t = dppu<0x140>(v); v = t > v ? t : v;
    const unsigned s0 = (unsigned)__builtin_amdgcn_readlane((int)v, 0), s1 = (unsigned)__builtin_amdgcn_readlane((int)v, 16);
    const unsigned s2 = (unsigned)__builtin_amdgcn_readlane((int)v, 32), s3 = (unsigned)__builtin_amdgcn_readlane((int)v, 48);
    const unsigned m0 = s0 > s1 ? s0 : s1, m1 = s2 > s3 ? s2 : s3;
    return m0 > m1 ? m0 : m1;
}
__device__ __forceinline__ float gelu_exact(float x) { return 0.5f * x * (1.f + erff(x * 0.70710678118654752f)); }
__device__ __forceinline__ float sigmoidf_(float x) { return 1.f / (1.f + __expf(-x)); }
__device__ __forceinline__ unsigned ord_key(float v) { unsigned u = __float_as_uint(v); return (u & 0x80000000u) ? ~u : (u | 0x80000000u); }
__device__ __forceinline__ const float* x_row(const P& p, int tok) { return tok < NPROMPT ? p.in[I_XP] + (size_t)tok * DM : p.in[I_XS] + (size_t)(tok - NPROMPT) * DM; }
__device__ __forceinline__ const float* prev_row(const float* pb, int tok) {
    if (tok < NPROMPT) return (tok & 2047) ? pb + (size_t)(tok - 1) * WBW : nullptr;
    const int s = tok - NPROMPT;
    return (s & 3) ? pb + (size_t)(tok - 1) * WBW : pb + (size_t)(NTOK + (s >> 2)) * WBW;
}

#define XB_TMO      128
#define XB_XCNT(j)  (256  + 64 * (j))
#define XB_XSUB(j)  (1280 + 64 * (j))
#define XB_XGEN(j)  (2304 + 64 * (j))
#define XB_TOP      3328
#define XB_TOPGEN   3392
#define XCD_BAR_WORDS 3456
#define XB_SPIN_CAP (1u << 18)
#define LAS __attribute__((address_space(3)))

__device__ __forceinline__ unsigned xb_ld(unsigned* p)              { return __hip_atomic_load(p, __ATOMIC_RELAXED, __HIP_MEMORY_SCOPE_AGENT); }
__device__ __forceinline__ unsigned xb_add(unsigned* p, unsigned v) { return __hip_atomic_fetch_add(p, v, __ATOMIC_RELAXED, __HIP_MEMORY_SCOPE_AGENT); }
__device__ __forceinline__ unsigned xb_xcc_id() { return (unsigned)__builtin_amdgcn_s_getreg((3 << 11) | 20) & 0xFu; }
#define XB_SPIN(cond, bar) do { unsigned _sp = 0; while (cond) { __builtin_amdgcn_s_sleep(1); \
    if ((++_sp & 255u) == 0u) { if (xb_ld(&(bar)[XB_TMO])) break; if (_sp > XB_SPIN_CAP) { atomicAdd(&(bar)[XB_TMO], 1u); break; } } } } while (0)

struct XcdBarrier {
    unsigned* bar; unsigned x;
    volatile LAS unsigned* st;
};

__device__ __forceinline__ XcdBarrier xcd_barrier_post(unsigned* bar, volatile LAS unsigned* st) {
    XcdBarrier b; b.bar = bar; b.x = xb_xcc_id(); b.st = st;
    if (threadIdx.x == 0) (void)xb_add(&bar[XB_XCNT(b.x)], 1u);
    return b;
}
__device__ __forceinline__ void xcd_barrier_complete(unsigned* bar, unsigned x, unsigned& nloc, unsigned& nx) {
    const unsigned G = gridDim.x * gridDim.y * gridDim.z;
    unsigned sum, cnt, mine, sp = 0u;
    for (;;) {
        sum = 0u; cnt = 0u; mine = 0u;
#pragma unroll
        for (unsigned j = 0; j < 16; ++j) { const unsigned c = xb_ld(&bar[XB_XCNT(j)]); sum += c; cnt += (c > 0u) ? 1u : 0u; mine = (j == x) ? c : mine; }
        if (sum == G) break;
        __builtin_amdgcn_s_sleep(1);
        if ((++sp & 255u) == 0u) { if (xb_ld(&bar[XB_TMO])) break; if (sp > XB_SPIN_CAP) { atomicAdd(&bar[XB_TMO], 1u); break; } }
    }
    nloc = mine > 0u ? mine : 1u; nx = cnt > 0u ? cnt : 1u;
}

__device__ __forceinline__ void xcd_barrier(const XcdBarrier& b) {
    asm volatile("s_waitcnt vmcnt(0)" ::: "memory");
    __syncthreads();
    if (threadIdx.x == 0) {
        unsigned* bar = b.bar;
        __builtin_amdgcn_s_waitcnt(0);
        unsigned nloc = b.st[0], nx = b.st[1];
        if (nloc == 0u) { xcd_barrier_complete(bar, b.x, nloc, nx); b.st[0] = nloc; b.st[1] = nx; }
        const unsigned old = xb_add(&bar[XB_XSUB(b.x)], 1u);
        const unsigned gen = old / nloc;
        if (old + 1u == (gen + 1u) * nloc) {
            __builtin_amdgcn_fence(__ATOMIC_RELEASE, "agent");
            asm volatile("s_waitcnt vmcnt(0)" ::: "memory");
            const unsigned og = xb_add(&bar[XB_TOP], 1u);
            const unsigned tg = og / nx;
            if (og + 1u == (tg + 1u) * nx) xb_add(&bar[XB_TOPGEN], 1u);
            else XB_SPIN(xb_ld(&bar[XB_TOPGEN]) == tg, bar);
            __builtin_amdgcn_fence(__ATOMIC_ACQUIRE, "agent");
            xb_add(&bar[XB_XGEN(b.x)], 1u);
            asm volatile("s_waitcnt vmcnt(0)" ::: "memory");
        } else {
            XB_SPIN(xb_ld(&bar[XB_XGEN(b.x)]) == gen, bar);
            __builtin_amdgcn_fence(__ATOMIC_ACQUIRE, "agent");
            asm volatile("s_waitcnt vmcnt(0)" ::: "memory");
        }
    }
    __syncthreads();
}


__device__ __forceinline__ void p0_transpose4(const float* __restrict__ W, int N, bf16_t* __restrict__ Wt, int kt0, int nt, float* lds) {
    const int tid = threadIdx.x;
    float v[4][8];
#pragma unroll
    for (int q = 0; q < 4; ++q)
#pragma unroll
        for (int i = 0; i < 8; ++i) {
            const int kl = (tid >> 6) + 8 * i, nl = tid & 63, n = nt * 64 + nl;
            v[q][i] = (n < N) ? W[(size_t)((kt0 + q) * 64 + kl) * N + n] : 0.f;
        }
#pragma unroll
    for (int q = 0; q < 4; ++q)
#pragma unroll
        for (int i = 0; i < 8; ++i) lds[q * 4160 + ((tid >> 6) + 8 * i) * 65 + (tid & 63)] = v[q][i];
    __syncthreads();
#pragma unroll
    for (int q = 0; q < 4; ++q) {
        const int nl = tid >> 3, kc = (tid & 7) * 8;
        const float* t = lds + q * 4160;
        uint4 o;
        o.x = pk_bf16(t[(kc + 0) * 65 + nl], t[(kc + 1) * 65 + nl]);
        o.y = pk_bf16(t[(kc + 2) * 65 + nl], t[(kc + 3) * 65 + nl]);
        o.z = pk_bf16(t[(kc + 4) * 65 + nl], t[(kc + 5) * 65 + nl]);
        o.w = pk_bf16(t[(kc + 6) * 65 + nl], t[(kc + 7) * 65 + nl]);
        *(uint4*)(Wt + (size_t)(nt * 64 + nl) * DM + (kt0 + q) * 64 + kc) = o;
    }
    __syncthreads();
}
__device__ __forceinline__ void p0_cvt(const float* __restrict__ src, bf16_t* __restrict__ dst, int item) {
    const size_t base = (size_t)item * 16384;
#pragma unroll
    for (int it = 0; it < 4; ++it) {
        const size_t idx = base + (size_t)(it * NTHR + threadIdx.x) * 8;
        const float4 a = *(const float4*)(src + idx), b = *(const float4*)(src + idx + 4);
        uint4 o; o.x = pk_bf16(a.x, a.y); o.y = pk_bf16(a.z, a.w); o.z = pk_bf16(b.x, b.y); o.w = pk_bf16(b.z, b.w);
        *(uint4*)(dst + idx) = o;
    }
}
__device__ __forceinline__ void p0_fp8rows(const float* __restrict__ src, unsigned char* __restrict__ dst, float* __restrict__ scales, int item) {
    const int w = threadIdx.x >> 6, lane = threadIdx.x & 63, row0 = item * 16 + w * 2;
    float4 v[2][8]; float am[2] = {0.f, 0.f};
#pragma unroll
    for (int q = 0; q < 2; ++q)
#pragma unroll
        for (int i = 0; i < 8; ++i) v[q][i] = *(const float4*)(src + (size_t)(row0 + q) * DM + i * 256 + lane * 4);
#pragma unroll
    for (int q = 0; q < 2; ++q) {
#pragma unroll
        for (int i = 0; i < 8; ++i) am[q] = fmaxf(am[q], fmaxf(fmaxf(fabsf(v[q][i].x), fabsf(v[q][i].y)), fmaxf(fabsf(v[q][i].z), fabsf(v[q][i].w))));
        am[q] = fmaxf(__uint_as_float(umax64(__float_as_uint(am[q]))), 1e-30f);
        const float inv = 448.f / am[q];
#pragma unroll
        for (int i = 0; i < 8; ++i) {
            int pk = __builtin_amdgcn_cvt_pk_fp8_f32(v[q][i].x * inv, v[q][i].y * inv, 0, false);
            pk = __builtin_amdgcn_cvt_pk_fp8_f32(v[q][i].z * inv, v[q][i].w * inv, pk, true);
            *(int*)(dst + (size_t)(row0 + q) * DM + i * 256 + lane * 4) = pk;
        }
        if (lane == 0) scales[row0 + q] = am[q] * (1.f / 448.f);
    }
}
__device__ __forceinline__ void p0_lora(const P& p, int item) {
    bf16_t* wl = (bf16_t*)(p.ws + OFF_WL);
#pragma unroll
    for (int j = 0; j < 8; ++j) {
        const int idx = item * 4096 + j * NTHR + threadIdx.x, n = idx & 1023, k = idx >> 10;
        const float v = k < 64 ? p.in[I_WUP][k * 1024 + n] : (k < 128 ? p.in[I_AUP][(k - 64) * 1024 + n] : p.in[I_GUP][(k - 128) * 1024 + n]);
        wl[n * 288 + k] = (bf16_t)(pk_bf16(v, 0.f) & 0xffffu);
    }
}
__device__ __forceinline__ void p0_rms(const P& p, int item) {
    const int w = threadIdx.x >> 6, lane = threadIdx.x & 63, row = item * 8 + w;
    const bool norm = row < NTOK;
    const float* src = norm ? x_row(p, row) : p.in[I_SSH] + (size_t)(row - NTOK) * DM;
    float4 v[8]; float ss = 0.f;
#pragma unroll
    for (int i = 0; i < 8; ++i) { v[i] = *(const float4*)(src + i * 256 + lane * 4); ss += v[i].x * v[i].x + v[i].y * v[i].y + v[i].z * v[i].z + v[i].w * v[i].w; }
    ss = sum64(ss);
    const float r = norm ? rsqrtf(ss * (1.f / DM) + 1e-6f) : 1.f;
    float* sh = nullptr;
    if (row < NPROMPT) { if ((row & 2047) == 2047) sh = p.out + O_SHP + (size_t)(row >> 11) * DM; }
    else if (row < NTOK) { const int s = row - NPROMPT; if ((s & 3) == 3) sh = p.out + O_SHS + (size_t)(s >> 2) * DM; }
    bf16_t* dst = (bf16_t*)(p.ws + OFF_A1) + (size_t)row * DM;
#pragma unroll
    for (int i = 0; i < 8; ++i) {
        float4 g = norm ? *(const float4*)(p.in[I_N1G] + i * 256 + lane * 4) : make_float4(1.f, 1.f, 1.f, 1.f);
        float4 y = make_float4(v[i].x * r * g.x, v[i].y * r * g.y, v[i].z * r * g.z, v[i].w * r * g.w);
        uint2 o; o.x = pk_bf16(y.x, y.y); o.y = pk_bf16(y.z, y.w);
        *(uint2*)(dst + i * 256 + lane * 4) = o;
        if (sh) *(float4*)(sh + i * 256 + lane * 4) = y;
    }
}
__device__ __forceinline__ void phase0(const P& p, unsigned char* lds) {
    constexpr int N_RMS = NROW1 / 8, N_TWIN = 88 * 8, N_TW = 32 * 8, N_SK = 2;
    constexpr int E0 = N_RMS, E1 = E0 + N_TWIN, E2 = E1 + N_TW, E3 = E2 + N_TW, E4 = E3 + N_SK, E7 = E4 + 72;
    for (int it = blockIdx.x; it < E7; it += gridDim.x) {
        if (it < E0) p0_rms(p, it);
        else if (it < E1) { const int j = it - E0; p0_transpose4(p.in[I_WIN], 5408, (bf16_t*)(p.ws + OFF_WIN), (j & 7) * 4, j >> 3, (float*)lds); }
        else if (it < E2) { const int j = it - E1; p0_transpose4(p.in[I_WOUT], 2048, (bf16_t*)(p.ws + OFF_WOUT), (j & 7) * 4, j >> 3, (float*)lds); }
        else if (it < E3) { const int j = it - E2; p0_transpose4(p.in[I_WQ], 2048, (bf16_t*)(p.ws + OFF_WQ), (j & 7) * 4, j >> 3, (float*)lds); }
        else if (it < E4) p0_cvt(p.in[I_SUBK], (bf16_t*)(p.ws + OFF_SK), it - E3);
        else p0_lora(p, it - E4);
    }
}

constexpr int G_STAGE = (128 + 256) * 144;
template <class Epi>
__device__ __forceinline__ void gemm_tile(const bf16_t* __restrict__ A, const bf16_t* __restrict__ Bt, int m0, int n0, unsigned char* lds, const Epi& epi) {
    const int tid = threadIdx.x, lane = tid & 63, w = tid >> 6, wm = w >> 2, wn = w & 3, r = lane & 31, hh = lane >> 5;
    u32x4 s0a0, s0a1, s0b0, s0b1, s0b2, s0b3, s1a0, s1a1, s1b0, s1b1, s1b2, s1b3;
    const bf16_t* ga[2]; const bf16_t* gb[4]; int la[2], lb[4];
#pragma unroll
    for (int i = 0; i < 2; ++i) { const int c = tid + i * NTHR, row = c >> 3, kc = c & 7; ga[i] = A + (size_t)(m0 + row) * DM + kc * 8; la[i] = row * 144 + kc * 16; }
#pragma unroll
    for (int i = 0; i < 4; ++i) { const int c = tid + i * NTHR, row = c >> 3, kc = c & 7; gb[i] = Bt + (size_t)(n0 + row) * DM + kc * 8; lb[i] = 128 * 144 + row * 144 + kc * 16; }
    f32x16 acc[2][2];
#pragma unroll
    for (int a = 0; a < 2; ++a)
#pragma unroll
        for (int b = 0; b < 2; ++b)
#pragma unroll
            for (int e = 0; e < 16; ++e) acc[a][b][e] = 0.f;
#define G_LOAD(S, KT)                                                                       \
    {                                                                                       \
        S##a0 = *(const u32x4*)(ga[0] + (KT) * 64); S##a1 = *(const u32x4*)(ga[1] + (KT) * 64); \
        S##b0 = *(const u32x4*)(gb[0] + (KT) * 64); S##b1 = *(const u32x4*)(gb[1] + (KT) * 64); \
        S##b2 = *(const u32x4*)(gb[2] + (KT) * 64); S##b3 = *(const u32x4*)(gb[3] + (KT) * 64); \
    }
#define G_STORE(S, ST)                                                                      \
    {                                                                                       \
        *(u32x4*)(lds + (ST) * G_STAGE + la[0]) = S##a0; *(u32x4*)(lds + (ST) * G_STAGE + la[1]) = S##a1; \
        *(u32x4*)(lds + (ST) * G_STAGE + lb[0]) = S##b0; *(u32x4*)(lds + (ST) * G_STAGE + lb[1]) = S##b1; \
        *(u32x4*)(lds + (ST) * G_STAGE + lb[2]) = S##b2; *(u32x4*)(lds + (ST) * G_STAGE + lb[3]) = S##b3; \
    }
    const int aoff = (wm * 64 + r) * 144 + hh * 16, boff = 128 * 144 + (wn * 64 + r) * 144 + hh * 16;
#define G_COMPUTE(ST)                                                                       \
    {                                                                                       \
        const unsigned char* cur = lds + (ST) * G_STAGE;                                    \
        _Pragma("unroll") for (int ks = 0; ks < 4; ++ks) {                                  \
            bf16x8 af[2], bfv[2];                                                           \
            _Pragma("unroll") for (int mi = 0; mi < 2; ++mi) af[mi] = *(const bf16x8*)(cur + aoff + mi * 32 * 144 + ks * 32);  \
            _Pragma("unroll") for (int ni = 0; ni < 2; ++ni) bfv[ni] = *(const bf16x8*)(cur + boff + ni * 32 * 144 + ks * 32); \
            _Pragma("unroll") for (int mi = 0; mi < 2; ++mi)                                \
                _Pragma("unroll") for (int ni = 0; ni < 2; ++ni) acc[mi][ni] = __builtin_amdgcn_mfma_f32_32x32x16_bf16(bfv[ni], af[mi], acc[mi][ni], 0, 0, 0); \
        }                                                                                   \
    }
    G_LOAD(s0, 0)
    G_LOAD(s1, 1)
    G_STORE(s0, 0)
    G_LOAD(s0, 2)
    __syncthreads();
#pragma unroll 1
    for (int kt = 0; kt < 32; kt += 2) {
        G_COMPUTE(0)
        G_STORE(s1, 1)
        G_LOAD(s1, (kt + 3 < 32 ? kt + 3 : 31))
        __syncthreads();
        G_COMPUTE(1)
        G_STORE(s0, 0)
        G_LOAD(s0, (kt + 4 < 32 ? kt + 4 : 31))
        __syncthreads();
    }
#undef G_LOAD
#undef G_STORE
#undef G_COMPUTE
    float* stg = (float*)lds;
#pragma unroll
    for (int mi = 0; mi < 2; ++mi)
#pragma unroll
        for (int ni = 0; ni < 2; ++ni)
#pragma unroll
            for (int g = 0; g < 4; ++g)
                *(float4*)(stg + mi * 16640 + (wm * 32 + r) * 260 + wn * 64 + ni * 32 + 8 * g + 4 * hh) =
                    make_float4(acc[mi][ni][4 * g], acc[mi][ni][4 * g + 1], acc[mi][ni][4 * g + 2], acc[mi][ni][4 * g + 3]);
    __syncthreads();
#pragma unroll
    for (int mi = 0; mi < 2; ++mi)
#pragma unroll
        for (int k = 0; k < 8; ++k) {
            const int idx = tid + k * NTHR, lrow = idx >> 6, c4 = (idx & 63) * 4;
            const float4 v = *(const float4*)(stg + mi * 16640 + lrow * 260 + c4);
            epi(m0 + (lrow >> 5) * 64 + mi * 32 + (lrow & 31), n0 + c4, v);
        }
    __syncthreads();
}

struct Epi1 {
    bf16_t* za; float* pb;
    __device__ __forceinline__ void operator()(int m, int n, float4 v) const {
        if (n < 2048) {
            if (m < NTOK) { uint2 o; o.x = pk_bf16(gelu_exact(v.x), gelu_exact(v.y)); o.y = pk_bf16(gelu_exact(v.z), gelu_exact(v.w)); *(uint2*)(za + (size_t)m * DM + n) = o; }
        } else if (n < 5408) *(float4*)(pb + (size_t)m * WBW + (n - 2048)) = v;
    }
};
struct Epi2 {
    const float* xp; const float* xs; float* h;
    __device__ __forceinline__ void operator()(int m, int n, float4 v) const {
        const float4 x = *(const float4*)((m < NPROMPT ? xp + (size_t)m * DM : xs + (size_t)(m - NPROMPT) * DM) + n);
        *(float4*)(h + (size_t)m * DM + n) = make_float4(x.x + v.x, x.y + v.y, x.z + v.z, x.w + v.w);
    }
};
struct Epi3 {
    bf16_t* q;
    __device__ __forceinline__ void operator()(int m, int n, float4 v) const { uint2 o; o.x = pk_bf16(v.x, v.y); o.y = pk_bf16(v.z, v.w); *(uint2*)(q + (size_t)m * DM + n) = o; }
};

__device__ __forceinline__ void phase2(const P& p, unsigned char* ldsb) {
    bf16_t* Xs = (bf16_t*)ldsb;
    const int tid = threadIdx.x, w = tid >> 6, lane = tid & 63, r = lane & 31, hh = lane >> 5;
    const bf16_t* za = (const bf16_t*)(p.ws + OFF_ZA);
    const float* pb = (const float*)(p.ws + OFF_PB);
    const bf16_t* wl = (const bf16_t*)(p.ws + OFF_WL);
    bf16_t* vn = (bf16_t*)(p.ws + OFF_VN);
    float* dec = (float*)(p.ws + OFF_DEC); float* aa = (float*)(p.ws + OFF_AA); float* gg = (float*)(p.ws + OFF_GG);
    for (int item = blockIdx.x; item < NTOK / 34; item += gridDim.x) {
        const int tok0 = item * 34;
#pragma unroll 1
        for (int tt = 0; tt < 5; ++tt) {
            const int tl = w + 8 * tt, tok = tok0 + tl;
            if (tl >= 34) break;
            float x[16];
#pragma unroll
            for (int hf = 0; hf < 2; ++hf) {
                const uint4 d = *(const uint4*)(za + (size_t)tok * DM + 1024 + hf * 512 + lane * 8);
                x[hf * 8 + 0] = bf_lo(d.x); x[hf * 8 + 1] = bf_hi(d.x); x[hf * 8 + 2] = bf_lo(d.y); x[hf * 8 + 3] = bf_hi(d.y);
                x[hf * 8 + 4] = bf_lo(d.z); x[hf * 8 + 5] = bf_hi(d.z); x[hf * 8 + 6] = bf_lo(d.w); x[hf * 8 + 7] = bf_hi(d.w);
            }
            const float* pr = pb + (size_t)tok * WBW + 3072;
            const float* pp = prev_row(pb, tok);
            float c0[5], c1[5];
#pragma unroll
            for (int i = 0; i < 5; ++i) { const int col = i * 64 + lane; c0[i] = col < 288 ? pr[col] : 0.f; c1[i] = (pp && col < 288) ? pp[3072 + col] : 0.f; }
            float s = 0.f;
#pragma unroll
            for (int i = 0; i < 16; ++i) s += x[i];
            const float mean = sum64(s) * (1.f / 1024.f);
            float s2 = 0.f;
#pragma unroll
            for (int i = 0; i < 16; ++i) { x[i] -= mean; s2 += x[i] * x[i]; }
            const float rstd = rsqrtf(sum64(s2) * (1.f / 1024.f) + 1e-5f);
            float* cv = nullptr;
            if (tok < NPROMPT) { const int t = tok & 2047; if (t >= 1920) cv = p.out + O_CVP + ((size_t)(tok >> 11) * 128 + (t - 1920)) * 1024; }
            else cv = p.out + O_CVS + (size_t)(tok - NPROMPT) * 1024;
#pragma unroll
            for (int hf = 0; hf < 2; ++hf) {
                const int c = hf * 512 + lane * 8;
                const float4 g0 = *(const float4*)(p.in[I_LNG] + c), g1 = *(const float4*)(p.in[I_LNG] + c + 4);
                const float4 b0 = *(const float4*)(p.in[I_LNB] + c), b1 = *(const float4*)(p.in[I_LNB] + c + 4);
                float y[8];
                y[0] = x[hf * 8 + 0] * rstd * g0.x + b0.x; y[1] = x[hf * 8 + 1] * rstd * g0.y + b0.y; y[2] = x[hf * 8 + 2] * rstd * g0.z + b0.z; y[3] = x[hf * 8 + 3] * rstd * g0.w + b0.w;
                y[4] = x[hf * 8 + 4] * rstd * g1.x + b1.x; y[5] = x[hf * 8 + 5] * rstd * g1.y + b1.y; y[6] = x[hf * 8 + 6] * rstd * g1.z + b1.z; y[7] = x[hf * 8 + 7] * rstd * g1.w + b1.w;
                uint4 o; o.x = pk_bf16(y[0], y[1]); o.y = pk_bf16(y[2], y[3]); o.z = pk_bf16(y[4], y[5]); o.w = pk_bf16(y[6], y[7]);
                *(uint4*)(vn + (size_t)tok * 1024 + c) = o;
                if (cv) { *(float4*)(cv + c) = make_float4(y[0], y[1], y[2], y[3]); *(float4*)(cv + c + 4) = make_float4(y[4], y[5], y[6], y[7]); }
            }
#pragma unroll
            for (int i = 0; i < 5; ++i) {
                const int col = i * 64 + lane;
                if (col < 288) {
                    const float q = c0[i] + (c1[i] - c0[i]) * p.in[I_MU][3072 + col];
                    const float xv = col < 64 ? tanhf(q) : (col < 128 ? q : sigmoidf_(q));
                    Xs[tl * 296 + col] = (bf16_t)(pk_bf16(xv, 0.f) & 0xffffu);
                }
            }
        }
        __syncthreads();
#pragma unroll 1
        for (int mt = 0; mt < 2; ++mt) {
        bf16x8 af[18];
#pragma unroll
        for (int ks = 0; ks < 18; ++ks) af[ks] = *(const bf16x8*)(Xs + (mt * 32 + r) * 296 + ks * 16 + hh * 8);
#pragma unroll 1
        for (int nt = 0; nt < 4; ++nt) {
            const int n = w * 128 + nt * 32 + r;
            const bf16_t* wrow = wl + (size_t)n * 288 + hh * 8;
            f32x16 aw, ac, ag;
#pragma unroll
            for (int e = 0; e < 16; ++e) { aw[e] = 0.f; ac[e] = 0.f; ag[e] = 0.f; }
#pragma unroll
            for (int ks = 0; ks < 4; ++ks) aw = __builtin_amdgcn_mfma_f32_32x32x16_bf16(af[ks], *(const bf16x8*)(wrow + ks * 16), aw, 0, 0, 0);
#pragma unroll
            for (int ks = 4; ks < 8; ++ks) ac = __builtin_amdgcn_mfma_f32_32x32x16_bf16(af[ks], *(const bf16x8*)(wrow + ks * 16), ac, 0, 0, 0);
#pragma unroll
            for (int ks = 8; ks < 18; ++ks) ag = __builtin_amdgcn_mfma_f32_32x32x16_bf16(af[ks], *(const bf16x8*)(wrow + ks * 16), ag, 0, 0, 0);
            const float w0 = p.in[I_W0][n], a0 = p.in[I_A0][n];
#pragma unroll
            for (int e = 0; e < 16; ++e) {
                const int tl = mt * 32 + (e & 3) + 8 * (e >> 2) + 4 * hh, tok = tok0 + tl;
                if (tl < 34) {
                    const float z = -(w0 + aw[e]);
                    const float sp = fmaxf(z, 0.f) + log1pf(__expf(-fabsf(z)));
                    dec[(size_t)tok * 1024 + n] = __expf(-__expf(-sp - 0.5f));
                    aa[(size_t)tok * 1024 + n] = sigmoidf_(a0 + ac[e]);
                    gg[(size_t)tok * 1024 + n] = ag[e];
                }
            }
        }
        }
        __syncthreads();
    }
}

struct StepV { float4 a0, a1, q0, q1, w0, w1, b0, b1, k0, k1; float v, br, kr; };
__device__ __forceinline__ void step_load(StepV& s, const float* lds, int tl, int j0, int row) {
    const float* b = lds + tl * 64 + j0;
    s.a0 = *(const float4*)(b); s.a1 = *(const float4*)(b + 4);
    s.q0 = *(const float4*)(b + 4096); s.q1 = *(const float4*)(b + 4096 + 4);
    s.w0 = *(const float4*)(b + 8192); s.w1 = *(const float4*)(b + 8192 + 4);
    s.b0 = *(const float4*)(b + 12288); s.b1 = *(const float4*)(b + 12288 + 4);
    s.k0 = *(const float4*)(b + 16384); s.k1 = *(const float4*)(b + 16384 + 4);
    s.v = lds[20480 + tl * 64 + row]; s.br = lds[32768 + tl]; s.kr = lds[32768 + 64 + tl];
}
__device__ __forceinline__ float step_compute(f32x2 (&S)[4], const StepV& s) {
    f32x2 t1 = S[0] * (f32x2){s.a0.x, s.a0.y} + S[1] * (f32x2){s.a0.z, s.a0.w} + S[2] * (f32x2){s.a1.x, s.a1.y} + S[3] * (f32x2){s.a1.z, s.a1.w};
    f32x2 t2 = S[0] * (f32x2){s.q0.x, s.q0.y} + S[1] * (f32x2){s.q0.z, s.q0.w} + S[2] * (f32x2){s.q1.x, s.q1.y} + S[3] * (f32x2){s.q1.z, s.q1.w};
    float sa = t1.x + t1.y, sy = t2.x + t2.y;
    sa += dppf<0xB1>(sa); sy += dppf<0xB1>(sy);
    sa += dppf<0x4E>(sa); sy += dppf<0x4E>(sy);
    sa += dppf<0x141>(sa); sy += dppf<0x141>(sy);
    S[0] = S[0] * (f32x2){s.w0.x, s.w0.y} + sa * (f32x2){s.b0.x, s.b0.y} + s.v * (f32x2){s.k0.x, s.k0.y};
    S[1] = S[1] * (f32x2){s.w0.z, s.w0.w} + sa * (f32x2){s.b0.z, s.b0.w} + s.v * (f32x2){s.k0.z, s.k0.w};
    S[2] = S[2] * (f32x2){s.w1.x, s.w1.y} + sa * (f32x2){s.b1.x, s.b1.y} + s.v * (f32x2){s.k1.x, s.k1.y};
    S[3] = S[3] * (f32x2){s.w1.z, s.w1.w} + sa * (f32x2){s.b1.z, s.b1.w} + s.v * (f32x2){s.k1.z, s.k1.w};
    return sy + sa * s.br + s.v * s.kr;
}
__device__ __forceinline__ void scan_item(const P& p, int tokbase, int T, int h, const float* s0, float* sout, float* lds) {
    const int tid = threadIdx.x, w = tid >> 6, lane = tid & 63, row = tid >> 3, seg = tid & 7, j0 = seg * 8;
    const float* pb = (const float*)(p.ws + OFF_PB);
    const float* dec = (const float*)(p.ws + OFF_DEC); const float* aa = (const float*)(p.ws + OFF_AA); const float* gg = (const float*)(p.ws + OFF_GG);
    bf16_t* a2 = (bf16_t*)(p.ws + OFF_A2);
    const int col = h * 64 + lane;
    const float mu_r = p.in[I_MU][col], mu_k = p.in[I_MU][1024 + col], mu_v = p.in[I_MU][2048 + col];
    const float kkw = p.in[I_KK][col], kaw = p.in[I_KA][col], rkw = p.in[I_RK][col], gng = p.in[I_GNG][col], gnb = p.in[I_GNB][col];
    f32x2 S[4];
    if (s0) {
        const float4 a = *(const float4*)(s0 + row * 64 + j0), b = *(const float4*)(s0 + row * 64 + j0 + 4);
        S[0] = (f32x2){a.x, a.y}; S[1] = (f32x2){a.z, a.w}; S[2] = (f32x2){b.x, b.y}; S[3] = (f32x2){b.z, b.w};
    } else { S[0] = S[1] = S[2] = S[3] = (f32x2){0.f, 0.f}; }
    float prw[9][3], pd[8], pa[8], pg[8];
#define PRE_LOAD(T0)                                                                                                   \
    if ((T0) + 8 * w < T) {                                                                                            \
        const int tokf = tokbase + (T0) + 8 * w;                                                                       \
        const float* pp = prev_row(pb, tokf);                                                                          \
        prw[0][0] = pp ? pp[col] : 0.f; prw[0][1] = pp ? pp[1024 + col] : 0.f; prw[0][2] = pp ? pp[2048 + col] : 0.f;  \
        _Pragma("unroll") for (int i = 0; i < 8; ++i) {                                                                \
            if ((T0) + 8 * w + i < T) {                                                                                \
                const float* pr = pb + (size_t)(tokf + i) * WBW;                                                       \
                prw[i + 1][0] = pr[col]; prw[i + 1][1] = pr[1024 + col]; prw[i + 1][2] = pr[2048 + col];               \
                pd[i] = dec[(size_t)(tokf + i) * 1024 + col]; pa[i] = aa[(size_t)(tokf + i) * 1024 + col]; pg[i] = gg[(size_t)(tokf + i) * 1024 + col]; \
            }                                                                                                          \
        }                                                                                                              \
    }
    PRE_LOAD(0)
    for (int t0 = 0; t0 < T; t0 += 64) {
        const int n = (T - t0) < 64 ? (T - t0) : 64;
#pragma unroll
        for (int i = 0; i < 8; ++i) {
            const int tl = 8 * w + i;
            if (tl < n) {
                const float r = prw[i + 1][0] + (prw[i][0] - prw[i + 1][0]) * mu_r, k = prw[i + 1][1] + (prw[i][1] - prw[i + 1][1]) * mu_k, v = prw[i + 1][2] + (prw[i][2] - prw[i + 1][2]) * mu_v;
                const float d = pd[i], a = pa[i];
                float kk = k * kkw;
                const float ssq = sum64(kk * kk);
                kk *= rsqrtf(fmaxf(ssq, 1e-24f));
                const float km = k * (1.f + (a - 1.f) * kaw);
                const float bb = kk * a;
                const float bon = sum64(r * km * rkw), br = sum64(bb * r), kr = sum64(km * r);
                lds[tl * 64 + lane] = -kk; lds[4096 + tl * 64 + lane] = d * r; lds[8192 + tl * 64 + lane] = d; lds[12288 + tl * 64 + lane] = bb;
                lds[16384 + tl * 64 + lane] = km; lds[20480 + tl * 64 + lane] = v; lds[24576 + tl * 64 + lane] = pg[i];
                if (lane == 0) { lds[32768 + tl] = br; lds[32832 + tl] = kr; lds[32896 + tl] = bon; }
            }
            __builtin_amdgcn_sched_barrier(0);
        }
        __syncthreads();
        if (t0 + 64 < T) { PRE_LOAD(t0 + 64) }
        {
            const float* bq = lds + j0;
            float4 a0 = *(const float4*)(bq), a1 = *(const float4*)(bq + 4), q0 = *(const float4*)(bq + 4096), q1 = *(const float4*)(bq + 4100);
#pragma unroll 1
            for (int tl = 0; tl < n; ++tl) {
                const float* b = bq + tl * 64;
                const float4 w0 = *(const float4*)(b + 8192), w1 = *(const float4*)(b + 8196), b0 = *(const float4*)(b + 12288), b1 = *(const float4*)(b + 12292);
                const float4 k0 = *(const float4*)(b + 16384), k1 = *(const float4*)(b + 16388);
                const float v = lds[20480 + tl * 64 + row], br = lds[32768 + tl], kr = lds[32832 + tl];
                const int tn = (tl + 1 < n) ? tl + 1 : tl;
                const float4 na0 = *(const float4*)(bq + tn * 64), na1 = *(const float4*)(bq + tn * 64 + 4), nq0 = *(const float4*)(bq + tn * 64 + 4096), nq1 = *(const float4*)(bq + tn * 64 + 4100);
                f32x2 t1 = S[0] * (f32x2){a0.x, a0.y} + S[1] * (f32x2){a0.z, a0.w} + S[2] * (f32x2){a1.x, a1.y} + S[3] * (f32x2){a1.z, a1.w};
                f32x2 t2 = S[0] * (f32x2){q0.x, q0.y} + S[1] * (f32x2){q0.z, q0.w} + S[2] * (f32x2){q1.x, q1.y} + S[3] * (f32x2){q1.z, q1.w};
                float sa = t1.x + t1.y, sy = t2.x + t2.y;
                sa += dppf<0xB1>(sa); sy += dppf<0xB1>(sy);
                sa += dppf<0x4E>(sa); sy += dppf<0x4E>(sy);
                sa += dppf<0x141>(sa); sy += dppf<0x141>(sy);
                S[0] = S[0] * (f32x2){w0.x, w0.y} + sa * (f32x2){b0.x, b0.y} + v * (f32x2){k0.x, k0.y};
                S[1] = S[1] * (f32x2){w0.z, w0.w} + sa * (f32x2){b0.z, b0.w} + v * (f32x2){k0.z, k0.w};
                S[2] = S[2] * (f32x2){w1.x, w1.y} + sa * (f32x2){b1.x, b1.y} + v * (f32x2){k1.x, k1.y};
                S[3] = S[3] * (f32x2){w1.z, w1.w} + sa * (f32x2){b1.z, b1.w} + v * (f32x2){k1.z, k1.w};
                if (seg == 0) lds[28672 + tl * 64 + row] = sy + sa * br + v * kr;
                a0 = na0; a1 = na1; q0 = nq0; q1 = nq1;
            }
        }
        __syncthreads();
#pragma unroll
        for (int i = 0; i < 8; ++i) {
            const int tl = w + 8 * i;
            if (tl < n) {
                const int tok = tokbase + t0 + tl;
                const float y = lds[28672 + tl * 64 + lane];
                const float mean = sum64(y) * (1.f / 64.f);
                const float yc = y - mean;
                const float var = sum64(yc * yc) * (1.f / 64.f);
                const float yn = yc * rsqrtf(var + 6.4e-4f) * gng + gnb;
                const float o = (yn + lds[32896 + tl] * lds[20480 + tl * 64 + lane]) * lds[24576 + tl * 64 + lane];
                a2[(size_t)tok * DM + 1024 + col] = (bf16_t)(pk_bf16(o, 0.f) & 0xffffu);
            }
            __builtin_amdgcn_sched_barrier(0);
        }
        __syncthreads();
    }
#undef PRE_LOAD
    *(float4*)(sout + row * 64 + j0) = make_float4(S[0].x, S[0].y, S[1].x, S[1].y);
    *(float4*)(sout + row * 64 + j0 + 4) = make_float4(S[2].x, S[2].y, S[3].x, S[3].y);
}

__device__ __forceinline__ void scan_prompt_q(const P& p, int b, int h, int rq, float* lds) {
    const int tid = threadIdx.x, w = tid >> 6, lane = tid & 63, row = (tid >> 4) & 15, seg = tid & 15, j0 = seg * 4;
    const float* pb = (const float*)(p.ws + OFF_PB);
    const float* dec = (const float*)(p.ws + OFF_DEC); const float* aa = (const float*)(p.ws + OFF_AA);
    float* yraw = (float*)(p.ws + OFF_YRAW); bf16_t* bonv = (bf16_t*)(p.ws + OFF_BONV);
    const int col = h * 64 + lane, tokbase = b * 2048;
    const float mu_r = p.in[I_MU][col], mu_k = p.in[I_MU][1024 + col], mu_v = p.in[I_MU][2048 + col];
    const float kkw = p.in[I_KK][col], kaw = p.in[I_KA][col], rkw = p.in[I_RK][col];
    f32x2 S[2]; S[0] = S[1] = (f32x2){0.f, 0.f};
    const bool prod = w >= 4; const int pw = w & 3;
#define DERIVE_CHUNK(C)                                                                                                \
    {                                                                                                                  \
        float* bufp = lds + ((C) & 1) * 12416;                                                                         \
        float prw[9][3], pd[8], pa[8];                                                                                 \
        const int tokf = tokbase + (C) * 32 + 8 * pw;                                                                  \
        const float* pp = prev_row(pb, tokf);                                                                          \
        prw[0][0] = pp ? pp[col] : 0.f; prw[0][1] = pp ? pp[1024 + col] : 0.f; prw[0][2] = pp ? pp[2048 + col] : 0.f;  \
        _Pragma("unroll") for (int i = 0; i < 8; ++i) {                                                                \
            const float* pr = pb + (size_t)(tokf + i) * WBW;                                                           \
            prw[i + 1][0] = pr[col]; prw[i + 1][1] = pr[1024 + col]; prw[i + 1][2] = pr[2048 + col];                   \
            pd[i] = dec[(size_t)(tokf + i) * 1024 + col]; pa[i] = aa[(size_t)(tokf + i) * 1024 + col];                 \
        }                                                                                                              \
        _Pragma("unroll") for (int i = 0; i < 8; ++i) {                                                                \
            const int tl = 8 * pw + i;                                                                                 \
            const float r = prw[i + 1][0] + (prw[i][0] - prw[i + 1][0]) * mu_r, k = prw[i + 1][1] + (prw[i][1] - prw[i + 1][1]) * mu_k, v = prw[i + 1][2] + (prw[i][2] - prw[i + 1][2]) * mu_v; \
            const float d = pd[i], a = pa[i];                                                                          \
            float kk = k * kkw;                                                                                        \
            const float ssq = sum64(kk * kk);                                                                          \
            kk *= rsqrtf(fmaxf(ssq, 1e-24f));                                                                          \
            const float km = k * (1.f + (a - 1.f) * kaw);                                                              \
            const float bb = kk * a;                                                                                   \
            const float bon = sum64(r * km * rkw), br = sum64(bb * r), kr = sum64(km * r);                             \
            bufp[tl * 64 + lane] = -kk; bufp[2048 + tl * 64 + lane] = d * r; bufp[4096 + tl * 64 + lane] = d; bufp[6144 + tl * 64 + lane] = bb; \
            bufp[8192 + tl * 64 + lane] = km; bufp[10240 + tl * 64 + lane] = v;                                        \
            if (lane == 0) { *(float2*)(bufp + 12288 + 2 * tl) = make_float2(0.125f * br, 0.125f * kr); }                                           \
            if (rq == 0) bonv[(size_t)(tokf + i) * 1024 + col] = (bf16_t)(pk_bf16(bon * v, 0.f) & 0xffffu);            \
            __builtin_amdgcn_sched_barrier(0);                                                                         \
        }                                                                                                              \
    }
#define FLUSH_Y(C)                                                                                                     \
    {                                                                                                                  \
        const int pt = tid & 255, t = pt >> 3, r2 = (pt & 7) * 2;                                                      \
        const float* yp_ = lds + 24832 + ((C) & 1) * 4096 + t * 128 + r2 * 8;                                          \
        const float4 p0_ = *(const float4*)(yp_), p1_ = *(const float4*)(yp_ + 4), p2_ = *(const float4*)(yp_ + 8), p3_ = *(const float4*)(yp_ + 12); \
        *(float2*)(yraw + (size_t)(tokbase + (C) * 32 + t) * 1024 + h * 64 + rq * 16 + r2) =                           \
            make_float2(((p0_.x + p0_.y) + (p0_.z + p0_.w)) + ((p1_.x + p1_.y) + (p1_.z + p1_.w)), ((p2_.x + p2_.y) + (p2_.z + p2_.w)) + ((p3_.x + p3_.y) + (p3_.z + p3_.w))); \
    }
    if (prod) { DERIVE_CHUNK(0) }
    __syncthreads();
#pragma unroll 1
    for (int c = 0; c < 64; ++c) {
        if (!prod) {
            const float* bq = lds + (c & 1) * 12416 + j0;
            float* sy_out = lds + 24832 + (c & 1) * 4096;
            float4 a = *(const float4*)(bq), q = *(const float4*)(bq + 2048), wv = *(const float4*)(bq + 4096), bv = *(const float4*)(bq + 6144), kv = *(const float4*)(bq + 8192);
            float v = bq[10240 - j0 + rq * 16 + row]; float2 bk = *(const float2*)(bq + 12288 - j0);
#pragma unroll 2
            for (int tl = 0; tl < 32; ++tl) {
                const int tn = (tl + 1 < 32) ? tl + 1 : tl;
                const float* bp = bq + tn * 64;
                const float4 na = *(const float4*)(bp), nq = *(const float4*)(bp + 2048), nw = *(const float4*)(bp + 4096), nb = *(const float4*)(bp + 6144), nk = *(const float4*)(bp + 8192);
                float nv = bq[10240 - j0 + tn * 64 + rq * 16 + row]; float2 nbk = *(const float2*)(bq + 12288 - j0 + 2 * tn);
                asm volatile("" : "+v"(nv), "+v"(nbk.x), "+v"(nbk.y));
                const f32x2 t1 = S[0] * (f32x2){a.x, a.y} + S[1] * (f32x2){a.z, a.w};
                const f32x2 t2 = S[0] * (f32x2){q.x, q.y} + S[1] * (f32x2){q.z, q.w};
                float sa = t1.x + t1.y, sy = t2.x + t2.y;
                sa += dppf<0xB1>(sa); sy += dppf<0xB1>(sy);
                sa += dppf<0x4E>(sa);
                sa += dppf<0x141>(sa);
                sa += dppf<0x140>(sa);
                S[0] = S[0] * (f32x2){wv.x, wv.y} + sa * (f32x2){bv.x, bv.y} + v * (f32x2){kv.x, kv.y};
                S[1] = S[1] * (f32x2){wv.z, wv.w} + sa * (f32x2){bv.z, bv.w} + v * (f32x2){kv.z, kv.w};
                sy_out[tl * 128 + row * 8 + (seg >> 1)] = __builtin_fmaf(sa, bk.x, __builtin_fmaf(v, bk.y, sy));
                a = na; q = nq; wv = nw; bv = nb; kv = nk; v = nv; bk = nbk;
            }
        } else {
            if (c > 0) FLUSH_Y(c - 1)
            if (c + 1 < 64) { DERIVE_CHUNK(c + 1) }
        }
        __syncthreads();
    }
    if (prod) FLUSH_Y(63)
    __syncthreads();
#undef DERIVE_CHUNK
#undef FLUSH_Y
    if (w < 4) *(float4*)(p.out + O_WKVP + (size_t)(b * 16 + h) * 4096 + (rq * 16 + row) * 64 + j0) = make_float4(S[0].x, S[0].y, S[1].x, S[1].y);
}
__device__ __forceinline__ void phase3b(const P& p) {
    const int w = threadIdx.x >> 6, lane = threadIdx.x & 63;
    const float* yraw = (const float*)(p.ws + OFF_YRAW); const bf16_t* bonv = (const bf16_t*)(p.ws + OFF_BONV); const float* gg = (const float*)(p.ws + OFF_GG);
    bf16_t* a2 = (bf16_t*)(p.ws + OFF_A2);
    float gng[16], gnb[16];
#pragma unroll
    for (int q = 0; q < 16; ++q) { gng[q] = p.in[I_GNG][q * 64 + lane]; gnb[q] = p.in[I_GNB][q * 64 + lane]; }
    for (int tok = w * (int)gridDim.x + (int)blockIdx.x; tok < NPROMPT; tok += 8 * (int)gridDim.x) {
        float y[16], bv[16], g[16];
#pragma unroll
        for (int q = 0; q < 16; ++q) {
            const size_t off = (size_t)tok * 1024 + q * 64 + lane;
            y[q] = yraw[off]; bv[q] = bf1(bonv[off]); g[q] = gg[off];
        }
#pragma unroll
        for (int q = 0; q < 16; ++q) {
            const float mean = sum64(y[q]) * (1.f / 64.f);
            const float yc = y[q] - mean;
            const float var = sum64(yc * yc) * (1.f / 64.f);
            const float yn = yc * rsqrtf(var + 6.4e-4f) * gng[q] + gnb[q];
            const float o = (yn + bv[q]) * g[q];
            a2[(size_t)tok * DM + 1024 + q * 64 + lane] = (bf16_t)(pk_bf16(o, 0.f) & 0xffffu);
        }
    }
}

__device__ __forceinline__ void scan_sample_wave(const P& p, int j, float* wl) {
    const int lane = threadIdx.x & 63, b = j >> 4, h = j & 15, col = h * 64 + lane, tokb = NPROMPT + b * 4;
    const float* pb = (const float*)(p.ws + OFF_PB);
    const float* dec = (const float*)(p.ws + OFF_DEC); const float* aa = (const float*)(p.ws + OFF_AA); const float* gg = (const float*)(p.ws + OFF_GG);
    bf16_t* a2 = (bf16_t*)(p.ws + OFF_A2);
    const float* s0 = p.in[I_SWKV] + (size_t)j * 4096 + lane * 64;
    float4 S[16];
#pragma unroll
    for (int i = 0; i < 16; ++i) S[i] = *(const float4*)(s0 + i * 4);
    float prw[5][3], pd[4], pa[4], gv[4];
    {
        const float* pp = pb + (size_t)(NTOK + b) * WBW;
        prw[0][0] = pp[col]; prw[0][1] = pp[1024 + col]; prw[0][2] = pp[2048 + col];
#pragma unroll
        for (int t = 0; t < 4; ++t) {
            const float* pr = pb + (size_t)(tokb + t) * WBW;
            prw[t + 1][0] = pr[col]; prw[t + 1][1] = pr[1024 + col]; prw[t + 1][2] = pr[2048 + col];
            pd[t] = dec[(size_t)(tokb + t) * 1024 + col]; pa[t] = aa[(size_t)(tokb + t) * 1024 + col]; gv[t] = gg[(size_t)(tokb + t) * 1024 + col];
        }
    }
    const float mu_r = p.in[I_MU][col], mu_k = p.in[I_MU][1024 + col], mu_v = p.in[I_MU][2048 + col];
    const float kkw = p.in[I_KK][col], kaw = p.in[I_KA][col], rkw = p.in[I_RK][col], gng = p.in[I_GNG][col], gnb = p.in[I_GNB][col];
    float vv[4], bon[4], brv[4], krv[4];
#pragma unroll
    for (int t = 0; t < 4; ++t) {
        const float r = prw[t + 1][0] + (prw[t][0] - prw[t + 1][0]) * mu_r, k = prw[t + 1][1] + (prw[t][1] - prw[t + 1][1]) * mu_k, v = prw[t + 1][2] + (prw[t][2] - prw[t + 1][2]) * mu_v;
        const float d = pd[t], a = pa[t];
        float kk = k * kkw;
        kk *= rsqrtf(fmaxf(sum64(kk * kk), 1e-24f));
        const float km = k * (1.f + (a - 1.f) * kaw), bb = kk * a;
        bon[t] = sum64(r * km * rkw); brv[t] = sum64(bb * r); krv[t] = sum64(km * r); vv[t] = v;
        wl[(t * 5 + 0) * 64 + lane] = -kk; wl[(t * 5 + 1) * 64 + lane] = d * r; wl[(t * 5 + 2) * 64 + lane] = d; wl[(t * 5 + 3) * 64 + lane] = bb; wl[(t * 5 + 4) * 64 + lane] = km;
    }
    __builtin_amdgcn_wave_barrier();
#pragma unroll 1
    for (int t = 0; t < 4; ++t) {
        const float* va = wl + (t * 5) * 64;
        float sa = 0.f, sy = 0.f;
#pragma unroll
        for (int i = 0; i < 16; ++i) {
            const float4 a4 = *(const float4*)(va + i * 4), q4 = *(const float4*)(va + 64 + i * 4);
            sa += S[i].x * a4.x + S[i].y * a4.y + S[i].z * a4.z + S[i].w * a4.w;
            sy += S[i].x * q4.x + S[i].y * q4.y + S[i].z * q4.z + S[i].w * q4.w;
        }
        const float v = t == 0 ? vv[0] : (t == 1 ? vv[1] : (t == 2 ? vv[2] : vv[3]));
        const float br = t == 0 ? brv[0] : (t == 1 ? brv[1] : (t == 2 ? brv[2] : brv[3]));
        const float kr = t == 0 ? krv[0] : (t == 1 ? krv[1] : (t == 2 ? krv[2] : krv[3]));
        const float bo = t == 0 ? bon[0] : (t == 1 ? bon[1] : (t == 2 ? bon[2] : bon[3]));
        const float g = t == 0 ? gv[0] : (t == 1 ? gv[1] : (t == 2 ? gv[2] : gv[3]));
        const float y = sy + sa * br + v * kr;
#pragma unroll
        for (int i = 0; i < 16; ++i) {
            const float4 w4 = *(const float4*)(va + 128 + i * 4), b4 = *(const float4*)(va + 192 + i * 4), k4 = *(const float4*)(va + 256 + i * 4);
            S[i].x = S[i].x * w4.x + sa * b4.x + v * k4.x; S[i].y = S[i].y * w4.y + sa * b4.y + v * k4.y;
            S[i].z = S[i].z * w4.z + sa * b4.z + v * k4.z; S[i].w = S[i].w * w4.w + sa * b4.w + v * k4.w;
        }
        const float mean = sum64(y) * (1.f / 64.f);
        const float yc = y - mean;
        const float var = sum64(yc * yc) * (1.f / 64.f);
        const float yn = yc * rsqrtf(var + 6.4e-4f) * gng + gnb;
        const float o = (yn + bo * v) * g;
        a2[(size_t)(tokb + t) * DM + 1024 + col] = (bf16_t)(pk_bf16(o, 0.f) & 0xffffu);
    }
    float* so = p.out + O_WKVS + (size_t)j * 4096 + lane * 64;
#pragma unroll
    for (int i = 0; i < 16; ++i) *(float4*)(so + i * 4) = S[i];
    __builtin_amdgcn_wave_barrier();
}

__device__ __forceinline__ void gate_item(const P& p, int b, int c, int h, unsigned char* lds) {
    bf16_t* As = (bf16_t*)lds; bf16_t* Bs = (bf16_t*)(lds + 128 * 272);
    const int tid = threadIdx.x, lane = tid & 63, w = tid >> 6, wm = w >> 2, wn = w & 3, r = lane & 31, hh = lane >> 5;
    const bf16_t* vn = (const bf16_t*)(p.ws + OFF_VN); const bf16_t* za = (const bf16_t*)(p.ws + OFF_ZA); bf16_t* a2 = (bf16_t*)(p.ws + OFF_A2);
    const int tokb = b * 2048 + c * 128;
    const float* wsh = p.in[I_WS] + (size_t)h * 16384;
#pragma unroll
    for (int i = 0; i < 8; ++i) {
        const int idx = tid + i * NTHR, t = idx >> 5, s4 = (idx & 31) * 4;
        float4 v = *(const float4*)(wsh + t * 128 + s4);
        if (s4 + 0 > t) v.x = 0.f; if (s4 + 1 > t) v.y = 0.f; if (s4 + 2 > t) v.z = 0.f; if (s4 + 3 > t) v.w = 0.f;
        uint2 o; o.x = pk_bf16(v.x, v.y); o.y = pk_bf16(v.z, v.w);
        *(uint2*)(As + t * 136 + s4) = o;
    }
#pragma unroll
    for (int i = 0; i < 4; ++i) {
        const int ch = tid + i * NTHR, s = ch >> 4, d8 = (ch & 15) * 8;
        const uint4 d = *(const uint4*)(vn + (size_t)(tokb + s) * 1024 + h * 128 + d8);
        Bs[(d8 + 0) * 136 + s] = (bf16_t)(d.x & 0xffff); Bs[(d8 + 1) * 136 + s] = (bf16_t)(d.x >> 16);
        Bs[(d8 + 2) * 136 + s] = (bf16_t)(d.y & 0xffff); Bs[(d8 + 3) * 136 + s] = (bf16_t)(d.y >> 16);
        Bs[(d8 + 4) * 136 + s] = (bf16_t)(d.z & 0xffff); Bs[(d8 + 5) * 136 + s] = (bf16_t)(d.z >> 16);
        Bs[(d8 + 6) * 136 + s] = (bf16_t)(d.w & 0xffff); Bs[(d8 + 7) * 136 + s] = (bf16_t)(d.w >> 16);
    }
    __syncthreads();
    f32x16 acc[2];
#pragma unroll
    for (int a = 0; a < 2; ++a)
#pragma unroll
        for (int e = 0; e < 16; ++e) acc[a][e] = 0.f;
#pragma unroll
    for (int ks = 0; ks < 8; ++ks) {
        const bf16x8 bfv = *(const bf16x8*)(Bs + (wn * 32 + r) * 136 + ks * 16 + hh * 8);
#pragma unroll
        for (int mi = 0; mi < 2; ++mi) {
            const bf16x8 af = *(const bf16x8*)(As + (wm * 64 + mi * 32 + r) * 136 + ks * 16 + hh * 8);
            acc[mi] = __builtin_amdgcn_mfma_f32_32x32x16_bf16(af, bfv, acc[mi], 0, 0, 0);
        }
    }
    const int d = wn * 32 + r, colc = h * 128 + d;
#pragma unroll
    for (int mi = 0; mi < 2; ++mi)
#pragma unroll
        for (int e = 0; e < 16; ++e) {
            const int t = wm * 64 + mi * 32 + (e & 3) + 8 * (e >> 2) + 4 * hh, tok = tokb + t;
            const float mixed = acc[mi][e] + p.in[I_BS][h * 128 + t];
            const float u = bf1(za[(size_t)tok * DM + colc]);
            a2[(size_t)tok * DM + colc] = (bf16_t)(pk_bf16(u * mixed, 0.f) & 0xffffu);
        }
    __syncthreads();
}
__device__ __forceinline__ void gate_sample_item(const P& p, int b) {
    const bf16_t* vn = (const bf16_t*)(p.ws + OFF_VN); const bf16_t* za = (const bf16_t*)(p.ws + OFF_ZA); bf16_t* a2 = (bf16_t*)(p.ws + OFF_A2);
    const int c = 2 * threadIdx.x, h = c >> 7, tokb = NPROMPT + b * 4;
    float v0[4], v1[4];
#pragma unroll
    for (int s = 0; s < 4; ++s) { const unsigned d = *(const unsigned*)(vn + (size_t)(tokb + s) * 1024 + c); v0[s] = bf_lo(d); v1[s] = bf_hi(d); }
#pragma unroll
    for (int t = 0; t < 4; ++t) {
        float m0 = p.in[I_BS][h * 128 + t], m1 = m0;
#pragma unroll
        for (int s = 0; s <= t; ++s) { const float wv = p.in[I_WS][(size_t)h * 16384 + t * 128 + s]; m0 += wv * v0[s]; m1 += wv * v1[s]; }
        const unsigned u = *(const unsigned*)(za + (size_t)(tokb + t) * DM + c);
        *(unsigned*)(a2 + (size_t)(tokb + t) * DM + c) = pk_bf16(bf_lo(u) * m0, bf_hi(u) * m1);
    }
}
__device__ __forceinline__ void phase3(const P& p, unsigned char* lds) {
    const int G = gridDim.x, bid = blockIdx.x;
    for (int it = bid; it < 256; it += G) scan_prompt_q(p, it >> 6, (it >> 2) & 15, it & 3, (float*)lds);
    for (int j = bid * 8 + (threadIdx.x >> 6); j < 2048; j += G * 8) scan_sample_wave(p, j, (float*)lds + (threadIdx.x >> 6) * 1280);
    __syncthreads();
    constexpr int N_G = 512, N_GS = 128;
    for (int it = bid; it < N_G + N_GS; it += G) {
        if (it < N_G) gate_item(p, it >> 7, (it >> 3) & 15, it & 7, lds);
        else gate_sample_item(p, it - N_G);
    }
}

__device__ __forceinline__ void phase5(const P& p) {
    const int w = threadIdx.x >> 6, lane = threadIdx.x & 63;
    const float* H = (const float*)(p.ws + OFF_H); bf16_t* a3 = (bf16_t*)(p.ws + OFF_A3);
    unsigned char* xq = p.ws + OFF_XQ; float* sx = (float*)(p.ws + OFF_SX);
    for (int row = w * (int)gridDim.x + (int)blockIdx.x; row < NTOK; row += 8 * (int)gridDim.x) {
        const float* src = H + (size_t)row * DM;
        float4 v[8]; float ss = 0.f;
#pragma unroll
        for (int i = 0; i < 8; ++i) { v[i] = *(const float4*)(src + i * 256 + lane * 4); ss += v[i].x * v[i].x + v[i].y * v[i].y + v[i].z * v[i].z + v[i].w * v[i].w; }
        ss = sum64(ss);
        const float r = rsqrtf(ss * (1.f / DM) + 1e-6f);
        float am = 0.f;
#pragma unroll
        for (int i = 0; i < 8; ++i) {
            const float4 g = *(const float4*)(p.in[I_N2G] + i * 256 + lane * 4);
            v[i] = make_float4(v[i].x * r * g.x, v[i].y * r * g.y, v[i].z * r * g.z, v[i].w * r * g.w);
            uint2 o; o.x = pk_bf16(v[i].x, v[i].y); o.y = pk_bf16(v[i].z, v[i].w);
            *(uint2*)(a3 + (size_t)row * DM + i * 256 + lane * 4) = o;
            am = fmaxf(am, fmaxf(fmaxf(fabsf(v[i].x), fabsf(v[i].y)), fmaxf(fabsf(v[i].z), fabsf(v[i].w))));
        }
        am = fmaxf(__uint_as_float(umax64(__float_as_uint(am))), 1e-30f);
        const float inv = 448.f / am;
#pragma unroll
        for (int i = 0; i < 8; ++i) {
            int pk = __builtin_amdgcn_cvt_pk_fp8_f32(v[i].x * inv, v[i].y * inv, 0, false);
            pk = __builtin_amdgcn_cvt_pk_fp8_f32(v[i].z * inv, v[i].w * inv, pk, true);
            *(int*)(xq + (size_t)row * DM + i * 256 + lane * 4) = pk;
        }
        if (lane == 0) sx[row] = am * (1.f / 448.f);
    }
}

#define TOP16_INSERT(T, X)                                                                  \
    {                                                                                       \
        unsigned x_ = (X);                                                                  \
        _Pragma("unroll") for (int i_ = 0; i_ < 16; ++i_) { const unsigned hi_ = T[i_] > x_ ? T[i_] : x_; x_ = T[i_] > x_ ? x_ : T[i_]; T[i_] = hi_; } \
    }
__device__ __forceinline__ void topk_item(const P& p, int item, unsigned char* lds) {
    float* Sc0 = (float*)lds; float* Sc1 = (float*)(lds + 66048);
    float* tS = (float*)(lds + 132096); unsigned char* tI = lds + 132096 + 17408;
    const int tid = threadIdx.x, lane = tid & 63, w = tid >> 6, wm = w >> 2, wn = w & 3, r = lane & 31, hh = lane >> 5;
    const bf16_t* qb = (const bf16_t*)(p.ws + OFF_QB); const bf16_t* skb = (const bf16_t*)(p.ws + OFF_SK);
    int* eidx = (int*)(p.ws + OFF_EIDX); float* gate = (float*)(p.ws + OFF_GATE);
    {
        const int tb = item >> 3, h = item & 7, tok0 = tb * 128;
#pragma unroll
        for (int c = 0; c < 2; ++c) {
            f32x16 acc[2];
#pragma unroll
            for (int a = 0; a < 2; ++a)
#pragma unroll
                for (int e2 = 0; e2 < 16; ++e2) acc[a][e2] = 0.f;
            const bf16_t* qa = qb + (size_t)(tok0 + wm * 64 + r) * DM + h * 256 + c * 128 + hh * 8;
            const bf16_t* kb = skb + (size_t)(c * 128 + wn * 32 + r) * 128 + hh * 8;
#pragma unroll
            for (int ks = 0; ks < 8; ++ks) {
                const bf16x8 bfv = *(const bf16x8*)(kb + ks * 16);
#pragma unroll
                for (int mi = 0; mi < 2; ++mi) {
                    const bf16x8 af = *(const bf16x8*)(qa + (size_t)mi * 32 * DM + ks * 16);
                    acc[mi] = __builtin_amdgcn_mfma_f32_32x32x16_bf16(af, bfv, acc[mi], 0, 0, 0);
                }
            }
            float* Sc = c ? Sc1 : Sc0;
#pragma unroll
            for (int mi = 0; mi < 2; ++mi)
#pragma unroll
                for (int e2 = 0; e2 < 16; ++e2) Sc[(wm * 64 + mi * 32 + (e2 & 3) + 8 * (e2 >> 2) + 4 * hh) * 129 + wn * 32 + r] = acc[mi][e2];
        }
        __syncthreads();
        if (w < 4) {
            const int c = w >> 1, row = (w & 1) * 64 + lane;
            const float* Sr = (c ? Sc1 : Sc0) + row * 129;
            unsigned t[16];
#pragma unroll
            for (int i = 0; i < 16; ++i) t[i] = 0u;
#pragma unroll 4
            for (int j = 0; j < 128; ++j) { const unsigned x = (ord_key(Sr[j]) & ~127u) | (unsigned)(127 - j); TOP16_INSERT(t, x) }
#pragma unroll
            for (int i = 0; i < 16; ++i) {
                const int idx = 127 - (int)(t[i] & 127u);
                tS[(c * 128 + row) * 17 + i] = Sr[idx]; tI[(c * 128 + row) * 16 + i] = (unsigned char)idx;
            }
        }
        __syncthreads();
        if (w < 2) {
            const int row = w * 64 + lane, tok = tok0 + row;
            float a[16], b[16];
#pragma unroll
            for (int i = 0; i < 16; ++i) { a[i] = tS[row * 17 + i]; b[i] = tS[(128 + row) * 17 + i]; }
            unsigned t[16];
#pragma unroll
            for (int i = 0; i < 16; ++i) t[i] = 0u;
#pragma unroll
            for (int i = 0; i < 16; ++i)
#pragma unroll
                for (int j = 0; j < 16 / (i + 1); ++j) { const unsigned x = (ord_key(a[i] + b[j]) & ~255u) | (unsigned)(255 - (i * 16 + j)); TOP16_INSERT(t, x) }
            float val[16]; int ex[16]; float se = 0.f;
#pragma unroll
            for (int k = 0; k < 16; ++k) {
                const int code = 255 - (int)(t[k] & 255u), ci = code >> 4, cj = code & 15;
                val[k] = tS[row * 17 + ci] + tS[(128 + row) * 17 + cj];
                ex[k] = (int)tI[row * 16 + ci] * 128 + (int)tI[(128 + row) * 16 + cj];
            }
            const float mx = val[0];
#pragma unroll
            for (int k = 0; k < 16; ++k) val[k] = __expf(val[k] - mx);
#pragma unroll
            for (int k = 0; k < 16; ++k) se += val[k];
            const float inv = 1.f / se;
            int4* ep = (int4*)(eidx + (size_t)tok * 128 + h * 16); float4* gp = (float4*)(gate + (size_t)tok * 128 + h * 16);
#pragma unroll
            for (int q = 0; q < 4; ++q) {
                ep[q] = make_int4(ex[4 * q], ex[4 * q + 1], ex[4 * q + 2], ex[4 * q + 3]);
                gp[q] = make_float4(val[4 * q] * inv, val[4 * q + 1] * inv, val[4 * q + 2] * inv, val[4 * q + 3] * inv);
            }
        }
        __syncthreads();
    }
}

__device__ __forceinline__ void phase8(const P& p, unsigned char* lds) {
    const int tid = threadIdx.x, lane = tid & 63, w = tid >> 6, r = lane & 15, g = lane >> 4;
    unsigned char* xs = lds + w * 2048;
    int* eb = (int*)(lds + 16384) + w * 128; float* gbuf = (float*)(lds + 20480) + w * 128; float* cb = (float*)(lds + 24576) + w * 128;
    const unsigned char* Uq = p.ws + OFF_UB; const unsigned char* Vq = p.ws + OFF_VB;
    const float* su = (const float*)(p.ws + OFF_SU); const float* sv = (const float*)(p.ws + OFF_SV);
    const unsigned char* xq = p.ws + OFF_XQ; const float* sx = (const float*)(p.ws + OFF_SX);
    const float* H = (const float*)(p.ws + OFF_H);
    const int* eidx = (const int*)(p.ws + OFF_EIDX); const float* gate = (const float*)(p.ws + OFF_GATE);
    const int G = gridDim.x, n_main = NTOK / (8 * G), n_tail_tok = NTOK - n_main * 8 * G, n_tail_it = (n_tail_tok + 2 * G - 1) / (2 * G);
    float* part = (float*)(lds + 32768) + w * 2048;
#pragma unroll 1
    for (int it = 0; it < n_main + n_tail_it; ++it) {
        const bool split = it >= n_main;
        int tok, g_lo, g_hi;
        if (!split) { tok = w * G + (int)blockIdx.x + it * 8 * G; g_lo = 0; g_hi = 8; }
        else { const int tt = (it - n_main) * 2 * G + (w >> 2) * G + (int)blockIdx.x; tok = tt < n_tail_tok ? n_main * 8 * G + tt : NTOK; g_lo = 2 * (w & 3); g_hi = g_lo + 2; }
        const bool active = tok < NTOK;
        float o[32];
#pragma unroll
        for (int i = 0; i < 32; ++i) o[i] = 0.f;
        if (active) {
        *(uint4*)(xs + lane * 32) = *(const uint4*)(xq + (size_t)tok * DM + lane * 32);
        *(uint4*)(xs + lane * 32 + 16) = *(const uint4*)(xq + (size_t)tok * DM + lane * 32 + 16);
        eb[lane] = eidx[(size_t)tok * 128 + lane]; eb[64 + lane] = eidx[(size_t)tok * 128 + 64 + lane];
        gbuf[lane] = gate[(size_t)tok * 128 + lane]; gbuf[64 + lane] = gate[(size_t)tok * 128 + 64 + lane];
        const float sxt = sx[tok];
        __builtin_amdgcn_wave_barrier();
#pragma unroll 1
        for (int grp = g_lo; grp < g_hi; ++grp) {
            const int e = eb[grp * 16 + r];
            const uint4* row = (const uint4*)(Uq + (size_t)e * DM + g * 32);
            f32x4 acc = {0.f, 0.f, 0.f, 0.f};
            uint4 A[32];
#pragma unroll
            for (int kk = 0; kk < 16; ++kk) { A[2 * kk] = row[kk * 8]; A[2 * kk + 1] = row[kk * 8 + 1]; }
#pragma unroll
            for (int kk = 0; kk < 16; ++kk) {
                const uint4 b0 = *(const uint4*)(xs + kk * 128 + g * 32), b1 = *(const uint4*)(xs + kk * 128 + g * 32 + 16);
                const i32x8 av = {(int)A[2 * kk].x, (int)A[2 * kk].y, (int)A[2 * kk].z, (int)A[2 * kk].w, (int)A[2 * kk + 1].x, (int)A[2 * kk + 1].y, (int)A[2 * kk + 1].z, (int)A[2 * kk + 1].w};
                const i32x8 bv = {(int)b0.x, (int)b0.y, (int)b0.z, (int)b0.w, (int)b1.x, (int)b1.y, (int)b1.z, (int)b1.w};
                acc = __builtin_amdgcn_mfma_scale_f32_16x16x128_f8f6f4(av, bv, acc, 0, 0, 0, 0, 0, 0);
            }
            if (r == 0) {
#pragma unroll
                for (int q = 0; q < 4; ++q) {
                    const int idx = grp * 16 + 4 * g + q, ee = eb[idx];
                    const float d = acc[q] * su[ee] * sxt;
                    cb[idx] = gbuf[idx] * gelu_exact(d) * sv[ee];
                }
            }
        }
        __builtin_amdgcn_wave_barrier();
#define VACC(D, I, C)                                                                                                   \
    {                                                                                                                  \
        f32x2 t;                                                                                                       \
        t = __builtin_amdgcn_cvt_pk_f32_fp8((int)(D).x, false); o[(I) * 16 + 0] += (C) * t.x; o[(I) * 16 + 1] += (C) * t.y;   \
        t = __builtin_amdgcn_cvt_pk_f32_fp8((int)(D).x, true);  o[(I) * 16 + 2] += (C) * t.x; o[(I) * 16 + 3] += (C) * t.y;   \
        t = __builtin_amdgcn_cvt_pk_f32_fp8((int)(D).y, false); o[(I) * 16 + 4] += (C) * t.x; o[(I) * 16 + 5] += (C) * t.y;   \
        t = __builtin_amdgcn_cvt_pk_f32_fp8((int)(D).y, true);  o[(I) * 16 + 6] += (C) * t.x; o[(I) * 16 + 7] += (C) * t.y;   \
        t = __builtin_amdgcn_cvt_pk_f32_fp8((int)(D).z, false); o[(I) * 16 + 8] += (C) * t.x; o[(I) * 16 + 9] += (C) * t.y;   \
        t = __builtin_amdgcn_cvt_pk_f32_fp8((int)(D).z, true);  o[(I) * 16 + 10] += (C) * t.x; o[(I) * 16 + 11] += (C) * t.y; \
        t = __builtin_amdgcn_cvt_pk_f32_fp8((int)(D).w, false); o[(I) * 16 + 12] += (C) * t.x; o[(I) * 16 + 13] += (C) * t.y; \
        t = __builtin_amdgcn_cvt_pk_f32_fp8((int)(D).w, true);  o[(I) * 16 + 14] += (C) * t.x; o[(I) * 16 + 15] += (C) * t.y; \
    }
#pragma unroll 1
        for (int e8 = g_lo * 16; e8 < g_hi * 16; e8 += 8) {
            uint4 d0[8], d1[8];
#pragma unroll
            for (int q = 0; q < 8; ++q) {
                const uint4* row = (const uint4*)(Vq + (size_t)eb[e8 + q] * DM) + lane;
                d0[q] = row[0]; d1[q] = row[64];
            }
#pragma unroll
            for (int q = 0; q < 8; ++q) {
                const float c = cb[e8 + q];
                asm volatile("" : "+v"(d0[q].x), "+v"(d0[q].y), "+v"(d0[q].z), "+v"(d0[q].w), "+v"(d1[q].x), "+v"(d1[q].y), "+v"(d1[q].z), "+v"(d1[q].w), "+v"(o[0]), "+v"(o[16]));
                VACC(d0[q], 0, c)
                VACC(d1[q], 1, c)
            }
        }
#undef VACC
        }
        bool fin = active && !split;
        if (split) {
            if (active) {
#pragma unroll
                for (int i = 0; i < 32; ++i) part[i * 64 + lane] = o[i];
            }
            __syncthreads();
            fin = active && (w & 3) == 0;
            if (fin) {
#pragma unroll
                for (int i = 0; i < 32; ++i) o[i] += part[2048 + i * 64 + lane] + part[4096 + i * 64 + lane] + part[6144 + i * 64 + lane];
            }
            __syncthreads();
        }
        if (fin) {
        float ss = 0.f;
#pragma unroll
        for (int i = 0; i < 2; ++i)
#pragma unroll
            for (int k = 0; k < 4; ++k) {
                const float4 hv = *(const float4*)(H + (size_t)tok * DM + i * 1024 + lane * 16 + k * 4);
                o[i * 16 + k * 4 + 0] += hv.x; o[i * 16 + k * 4 + 1] += hv.y; o[i * 16 + k * 4 + 2] += hv.z; o[i * 16 + k * 4 + 3] += hv.w;
#pragma unroll
                for (int e = 0; e < 4; ++e) ss += o[i * 16 + k * 4 + e] * o[i * 16 + k * 4 + e];
            }
        ss = sum64(ss);
        const float rs = rsqrtf(ss * (1.f / DM) + 1e-6f);
        float* y = p.out + O_Y + (size_t)tok * DM;
#pragma unroll
        for (int i = 0; i < 2; ++i)
#pragma unroll
            for (int k = 0; k < 4; ++k) {
                const float4 gv = *(const float4*)(p.in[I_FG] + i * 1024 + lane * 16 + k * 4);
                *(float4*)(y + i * 1024 + lane * 16 + k * 4) = make_float4(o[i * 16 + k * 4 + 0] * rs * gv.x, o[i * 16 + k * 4 + 1] * rs * gv.y, o[i * 16 + k * 4 + 2] * rs * gv.z, o[i * 16 + k * 4 + 3] * rs * gv.w);
            }
        }
        __builtin_amdgcn_wave_barrier();
    }
}

__device__ __forceinline__ void fp8_table_filler(const float* src, unsigned char* dst, float* scales) {
    const int G = gridDim.x, nb = (68 * 8) % G;
    if (nb == 0) { for (int it = blockIdx.x; it < 1024; it += G) p0_fp8rows(src, dst, scales, it); }
    else if ((int)blockIdx.x >= nb) { for (int it = blockIdx.x - nb; it < 1024; it += G - nb) p0_fp8rows(src, dst, scales, it); }
}

#ifndef ONLY_PHASE
#define ONLY_PHASE -1
#endif
#ifndef DBL_PHASE
#define DBL_PHASE -1
#endif
#ifndef DBG_AFTER
#define DBG_AFTER 99
#endif
#ifndef DBG_WHAT
#define DBG_WHAT 0
#endif
__device__ __forceinline__ void dbg_dump(const P& p) {
    const size_t n = (size_t)NTOK * DM;
    for (size_t i = (size_t)blockIdx.x * NTHR + threadIdx.x; i < n; i += (size_t)gridDim.x * NTHR) {
        float v = 0.f;
        if (DBG_WHAT == 0) v = bf1(((const bf16_t*)(p.ws + OFF_A2))[i]);
        else if (DBG_WHAT == 1) v = bf1(((const bf16_t*)(p.ws + OFF_ZA))[i]);
        else if (DBG_WHAT == 2) v = ((const float*)(p.ws + OFF_PB))[i];
        else if (DBG_WHAT == 3) v = ((const float*)(p.ws + OFF_PB))[i + 11000000];
        else if (DBG_WHAT == 4) v = ((const float*)(p.ws + OFF_DEC))[i];
        else if (DBG_WHAT == 5) v = ((const float*)(p.ws + OFF_GG))[i & 8388607] + ((const float*)(p.ws + OFF_AA))[i & 8388607];
        else if (DBG_WHAT == 6) v = ((const float*)(p.ws + OFF_H))[i];
        else if (DBG_WHAT == 7) v = bf1(((const bf16_t*)(p.ws + OFF_QB))[i]);
        else if (DBG_WHAT == 8) v = (i < (size_t)NTOK * 128) ? (float)((const int*)(p.ws + OFF_EIDX))[i] : ((i < (size_t)NTOK * 256) ? ((const float*)(p.ws + OFF_GATE))[i - (size_t)NTOK * 128] : 0.f);
        else if (DBG_WHAT == 10) v = bf1(((const bf16_t*)(p.ws + OFF_A3))[i]);
        else if (DBG_WHAT == 9) v = bf1(((const bf16_t*)(p.ws + OFF_VN))[i >> 1]);
        p.out[i] = v;
    }
}
typedef const __attribute__((address_space(4))) P* cP4;
__device__ __forceinline__ P load_params() {
#if defined(__HIP_DEVICE_COMPILE__)
    unsigned long long ka = (unsigned long long)__builtin_amdgcn_kernarg_segment_ptr();
    asm volatile("" : "+s"(ka));
    P r;
#pragma unroll
    for (int i = 0; i < 28; ++i) r.in[i] = ((cP4)ka)->in[i];
    r.out = ((cP4)ka)->out; r.ws = ((cP4)ka)->ws;
    return r;
#else
    return P{};
#endif
}
#define PHASE_BEGIN(n) if ((n) == DBG_AFTER + 1 && ph_lo <= (n) && (n) <= ph_hi) { const P p = load_params(); dbg_dump(p); } if ((ONLY_PHASE < 0 || (n) == ONLY_PHASE) && (n) <= DBG_AFTER && ph_lo <= (n) && (n) <= ph_hi) { const P p = load_params(); for (int rep_ = 0; rep_ < ((n) == DBL_PHASE ? 2 : 1); ++rep_) { if (rep_) xcd_barrier(xb_);
#define PHASE_END(n) } } if (ph_lo <= (n) && (n) < ph_hi) xcd_barrier(xb_); asm volatile("" ::: "memory");
__global__ void __launch_bounds__(NTHR) mega(P p_arg, int ph_lo, int ph_hi) {
    __shared__ __attribute__((aligned(16))) unsigned char lds[LDS_BYTES];
    __shared__ uint4 xb_words;
    if (threadIdx.x == 0) xb_words = make_uint4(0u, 0u, 0u, 0u);
    __syncthreads();
    const XcdBarrier xb_ = xcd_barrier_post((unsigned*)(load_params().ws + OFF_BAR), (volatile LAS unsigned*)&xb_words);
    if (ph_lo > ph_hi) cg::this_grid().sync();
    PHASE_BEGIN(0) phase0(p, lds); PHASE_END(0)
    PHASE_BEGIN(1) { Epi1 e{(bf16_t*)(p.ws + OFF_ZA), (float*)(p.ws + OFF_PB)};
        const int G = gridDim.x, GR = (69 * 22 + G - 1) / G * G;
        for (int L = blockIdx.x; L < GR; L += G) {
            int id = L;
            if ((G & 7) == 0) { const int rnd = L / G, inr = L % G; id = rnd * G + (inr & 7) * (G >> 3) + (inr >> 3); }
            if (id >= 69 * 22) continue;
            const int g8 = id / (8 * 22), fm = g8 * 8, gsz = (69 - fm) < 8 ? (69 - fm) : 8, rem = id - g8 * (8 * 22);
            gemm_tile((const bf16_t*)(p.ws + OFF_A1), (const bf16_t*)(p.ws + OFF_WIN), (fm + rem % gsz) * 128, (rem / gsz) * 256, lds, e);
        } } PHASE_END(1)
    PHASE_BEGIN(2) phase2(p, lds); PHASE_END(2)
    PHASE_BEGIN(3) phase3(p, lds); PHASE_END(3)
    PHASE_BEGIN(4) phase3b(p); PHASE_END(4)
    PHASE_BEGIN(5) { Epi2 e{p.in[I_XP], p.in[I_XS], (float*)(p.ws + OFF_H)};
        for (int t = blockIdx.x; t < 68 * 8; t += gridDim.x) gemm_tile((const bf16_t*)(p.ws + OFF_A2), (const bf16_t*)(p.ws + OFF_WOUT), (t >> 3) * 128, (t & 7) * 256, lds, e);
        fp8_table_filler(p.in[I_UT], p.ws + OFF_UB, (float*)(p.ws + OFF_SU)); } PHASE_END(5)
    PHASE_BEGIN(6) phase5(p); PHASE_END(6)
    PHASE_BEGIN(7) { Epi3 e{(bf16_t*)(p.ws + OFF_QB)};
        for (int t = blockIdx.x; t < 68 * 8; t += gridDim.x) {
            gemm_tile((const bf16_t*)(p.ws + OFF_A3), (const bf16_t*)(p.ws + OFF_WQ), (t >> 3) * 128, (t & 7) * 256, lds, e);
            __syncthreads();
            topk_item(p, t, lds);
        }
        fp8_table_filler(p.in[I_VT], p.ws + OFF_VB, (float*)(p.ws + OFF_SV)); } PHASE_END(7)
    PHASE_BEGIN(8) phase8(p, lds); PHASE_END(8)
}

extern "C" void kernel_launch(void* const* d_in, const int* in_sizes, int n_in, void* d_out, int out_size, void* d_ws, size_t ws_size, hipStream_t stream) {
    static int grid = 0;
    if (grid == 0) {
        if (n_in != 28 || ws_size < WS_END) { fprintf(stderr, "kernel_launch: need 28 inputs and %zu bytes of workspace (got %d, %zu)\n", (size_t)WS_END, n_in, ws_size); grid = -1; return; }
        int dev = 0, cus = 0, per_cu = 0;
        hipGetDevice(&dev);
        hipDeviceGetAttribute(&cus, hipDeviceAttributeMultiprocessorCount, dev);
        hipOccupancyMaxActiveBlocksPerMultiprocessor(&per_cu, (const void*)mega, NTHR, 0);
        if (per_cu < 1) per_cu = 1;
        grid = cus * per_cu;
        if (grid < 128) { fprintf(stderr, "kernel_launch: grid %d too small\n", grid); grid = -1; return; }
    }
    if (grid < 0) return;
    P p{};
    for (int i = 0; i < 28; ++i) p.in[i] = (const float*)d_in[i];
    p.out = (float*)d_out; p.ws = (unsigned char*)d_ws;
#if ONE_LAUNCH
    hipMemsetAsync((unsigned char*)d_ws + OFF_BAR, 0, 16384, stream);
    int lo = 0, hi = (DBG_AFTER < N_PHASES - 1) ? DBG_AFTER + 1 : N_PHASES - 1;
    void* args[] = {&p, &lo, &hi};
    hipError_t e = hipLaunchCooperativeKernel((const void*)mega, dim3(grid), dim3(NTHR), args, 0, stream);
    if (e != hipSuccess) fprintf(stderr, "cooperative launch failed: %s (grid %d)\n", hipGetErrorString(e), grid);
#else
    for (int ph = 0; ph < N_PHASES; ++ph) hipLaunchKernelGGL(mega, dim3(grid), dim3(NTHR), 0, stream, p, ph, ph);
#endif
}
```

```cpp
#include <hip/hip_runtime.h>
#include <hip/hip_cooperative_groups.h>
#include <cstdio>
namespace cg = cooperative_groups;

#ifndef ONE_LAUNCH
#define ONE_LAUNCH 1
#endif

typedef unsigned short bf16_t;
typedef short bf16x8 __attribute__((ext_vector_type(8)));
typedef float f32x2 __attribute__((ext_vector_type(2)));
typedef float f32x4 __attribute__((ext_vector_type(4)));
typedef float f32x16 __attribute__((ext_vector_type(16)));
typedef __bf16 bf2_t __attribute__((ext_vector_type(2)));
typedef int i32x8 __attribute__((ext_vector_type(8)));
typedef unsigned u32x4 __attribute__((ext_vector_type(4)));

constexpr int NTHR = 512;
constexpr int DM = 2048, NTOK = 8704, NPROMPT = 8192, NROW1 = 8832, WINP = 5632, WBW = 3360;
constexpr int N_PHASES = 9;

constexpr size_t O_Y = 0, O_WKVP = 17825792, O_SHP = 18087936, O_CVP = 18096128, O_WKVS = 18620416, O_SHS = 27009024, O_CVS = 27271168;
constexpr size_t OFF_UB = 0, OFF_VB = 67108864, OFF_WOUT = 134217728, OFF_WQ = 142606336, OFF_SK = 150994944, OFF_PB = 151060480,
                 OFF_ZA = 269762560, OFF_A1 = 305414144, OFF_WIN = 341590016, OFF_DEC = 364658688, OFF_AA = OFF_DEC + 35651584, OFF_GG = OFF_AA + 35651584,
                 OFF_YRAW = OFF_GG + 35651584, OFF_BONV = OFF_YRAW + 33554432, OFF_BAR = OFF_BONV + 16777216, WS_END = OFF_BAR + 16384;
constexpr size_t OFF_SU = OFF_UB + 33554432, OFF_SV = OFF_VB + 33554432, OFF_XQ = OFF_UB + 41943040, OFF_SX = OFF_UB + 60817408, OFF_WL = OFF_UB + 62914560;
constexpr size_t OFF_VN = OFF_A1, OFF_A2 = OFF_A1 + 17825792, OFF_H = OFF_PB, OFF_A3 = OFF_PB + 71303168, OFF_QB = OFF_ZA, OFF_EIDX = OFF_DEC, OFF_GATE = OFF_DEC + 4456448;

struct P { const float* in[28]; float* out; unsigned char* ws; };

enum { I_XP = 0, I_XS, I_SWKV, I_SSH, I_N1G, I_WIN, I_LNG, I_LNB, I_WS, I_BS, I_MU, I_W0, I_WUP, I_A0, I_AUP, I_GUP, I_KK, I_KA, I_RK, I_GNG, I_GNB, I_WOUT, I_N2G, I_WQ, I_SUBK, I_UT, I_VT, I_FG };

constexpr int LDS_BYTES = 153600;

__device__ __forceinline__ unsigned pk_bf16(float lo, float hi) { const f32x2 v = {lo, hi}; const bf2_t r = __builtin_convertvector(v, bf2_t); return __builtin_bit_cast(unsigned, r); }
__device__ __forceinline__ float bf_lo(unsigned u) { return __uint_as_float(u << 16); }
__device__ __forceinline__ float bf_hi(unsigned u) { return __uint_as_float(u & 0xffff0000u); }
__device__ __forceinline__ float bf1(bf16_t b) { return __uint_as_float(((unsigned)b) << 16); }
template <int C> __device__ __forceinline__ float dppf(float v) { return __int_as_float(__builtin_amdgcn_update_dpp(0, __float_as_int(v), C, 0xf, 0xf, true)); }
__device__ __forceinline__ float sum8(float v) { v += dppf<0xB1>(v); v += dppf<0x4E>(v); v += dppf<0x141>(v); return v; }
__device__ __forceinline__ float sum16(float v) { v = sum8(v); v += dppf<0x140>(v); return v; }
__device__ __forceinline__ float rdlane(float v, int l) { return __int_as_float(__builtin_amdgcn_readlane(__float_as_int(v), l)); }
__device__ __forceinline__ float sum64(float v) { v = sum16(v); return (rdlane(v, 0) + rdlane(v, 16)) + (rdlane(v, 32) + rdlane(v, 48)); }
template <int C> __device__ __forceinline__ unsigned dppu(unsigned v) { return (unsigned)__builtin_amdgcn_update_dpp(0, (int)v, C, 0xf, 0xf, true); }
__device__ __forceinline__ unsigned umax64(unsigned v) {
    unsigned t;
    t = dppu<0xB1>(v); v = t > v ? t : v;
    t = dppu<0x4E>(v); v = t > v ? t : v;
    t = dppu<0x141>(v); v = t > v ? t : v;
    t = dppu<0x140>(v); v = t > v ? t : v;
    const unsigned s0 = (unsigned)__builtin_amdgcn_readlane((int)v, 0), s1 = (unsigned)__builtin_amdgcn_readlane((int)v, 16);
    const unsigned s2 = (unsigned)__builtin_amdgcn_readlane((int)v, 32), s3 = (unsigned)__builtin_amdgcn_readlane((int)v, 48);
    const unsigned m0 = s0 > s1 ? s0 : s1, m1 = s2 > s3 ? s2 : s3;
    return m0 > m1 ? m0 : m1;
}
__device__ __forceinline__ float gelu_exact(float x) { return 0.5f * x * (1.f + erff(x * 0.70710678118654752f)); }
__device__ __forceinline__ float sigmoidf_(float x) { return 1.f / (1.f + __expf(-x)); }
__device__ __forceinline__ unsigned ord_key(float v) { unsigned u = __float_as_uint(v); return (u & 0x80000000u) ? ~u : (u | 0x80000000u); }
__device__ __forceinline__ const float* x_row(const P& p, int tok) { return tok < NPROMPT ? p.in[I_XP] + (size_t)tok * DM : p.in[I_XS] + (size_t)(tok - NPROMPT) * DM; }
__device__ __forceinline__ const float* prev_row(const float* pb, int tok) {
    if (tok < NPROMPT) return (tok & 2047) ? pb + (size_t)(tok - 1) * WBW : nullptr;
    const int s = tok - NPROMPT;
    return (s & 3) ? pb + (size_t)(tok - 1) * WBW : pb + (size_t)(NTOK + (s >> 2)) * WBW;
}

#define XB_TMO      128
#define XB_XCNT(j)  (256  + 64 * (j))
#define XB_XSUB(j)  (1280 + 64 * (j))
#define XB_XGEN(j)  (2304 + 64 * (j))
#define XB_TOP      3328
#define XB_TOPGEN   3392
#define XCD_BAR_WORDS 3456
#define XB_SPIN_CAP (1u << 18)
#define LAS __attribute__((address_space(3)))

__device__ __forceinline__ unsigned xb_ld(unsigned* p)              { return __hip_atomic_load(p, __ATOMIC_RELAXED, __HIP_MEMORY_SCOPE_AGENT); }
__device__ __forceinline__ unsigned xb_add(unsigned* p, unsigned v) { return __hip_atomic_fetch_add(p, v, __ATOMIC_RELAXED, __HIP_MEMORY_SCOPE_AGENT); }
__device__ __forceinline__ unsigned xb_xcc_id() { return (unsigned)__builtin_amdgcn_s_getreg((3 << 11) | 20) & 0xFu; }
#define XB_SPIN(cond, bar) do { unsigned _sp = 0; while (cond) { __builtin_amdgcn_s_sleep(1); \
    if ((++_sp & 255u) == 0u) { if (xb_ld(&(bar)[XB_TMO])) break; if (_sp > XB_SPIN_CAP) { atomicAdd(&(bar)[XB_TMO], 1u); break; } } } } while (0)

struct XcdBarrier {
    unsigned* bar; unsigned x;
    volatile LAS unsigned* st;
};

__device__ __forceinline__ XcdBarrier xcd_barrier_post(unsigned* bar, volatile LAS unsigned* st) {
    XcdBarrier b; b.bar = bar; b.x = xb_xcc_id(); b.st = st;
    if (threadIdx.x == 0) (void)xb_add(&bar[XB_XCNT(b.x)], 1u);
    return b;
}
__device__ __forceinline__ void xcd_barrier_complete(unsigned* bar, unsigned x, unsigned& nloc, unsigned& nx) {
    const unsigned G = gridDim.x * gridDim.y * gridDim.z;
    unsigned sum, cnt, mine, sp = 0u;
    for (;;) {
        sum = 0u; cnt = 0u; mine = 0u;
#pragma unroll
        for (unsigned j = 0; j < 16; ++j) { const unsigned c = xb_ld(&bar[XB_XCNT(j)]); sum += c; cnt += (c > 0u) ? 1u : 0u; mine = (j == x) ? c : mine; }
        if (sum == G) break;
        __builtin_amdgcn_s_sleep(1);
        if ((++sp & 255u) == 0u) { if (xb_ld(&bar[XB_TMO])) break; if (sp > XB_SPIN_CAP) { atomicAdd(&bar[XB_TMO], 1u); break; } }
    }
    nloc = mine > 0u ? mine : 1u; nx = cnt > 0u ? cnt : 1u;
}

__device__ __forceinline__ void xcd_barrier(const XcdBarrier& b) {
    asm volatile("s_waitcnt vmcnt(0)" ::: "memory");
    __syncthreads();
    if (threadIdx.x == 0) {
        unsigned* bar = b.bar;
        __builtin_amdgcn_s_waitcnt(0);
        unsigned nloc = b.st[0], nx = b.st[1];
        if (nloc == 0u) { xcd_barrier_complete(bar, b.x, nloc, nx); b.st[0] = nloc; b.st[1] = nx; }
        const unsigned old = xb_add(&bar[XB_XSUB(b.x)], 1u);
        const unsigned gen = old / nloc;
        if (old + 1u == (gen + 1u) * nloc) {
            __builtin_amdgcn_fence(__ATOMIC_RELEASE, "agent");
            asm volatile("s_waitcnt vmcnt(0)" ::: "memory");
            const unsigned og = xb_add(&bar[XB_TOP], 1u);
            const unsigned tg = og / nx;
            if (og + 1u == (tg + 1u) * nx) xb_add(&bar[XB_TOPGEN], 1u);
            else XB_SPIN(xb_ld(&bar[XB_TOPGEN]) == tg, bar);
            __builtin_amdgcn_fence(__ATOMIC_ACQUIRE, "agent");
            xb_add(&bar[XB_XGEN(b.x)], 1u);
            asm volatile("s_waitcnt vmcnt(0)" ::: "memory");
        } else {
            XB_SPIN(xb_ld(&bar[XB_XGEN(b.x)]) == gen, bar);
            __builtin_amdgcn_fence(__ATOMIC_ACQUIRE, "agent");
            asm volatile("s_waitcnt vmcnt(0)" ::: "memory");
        }
    }
    __syncthreads();
}


__device__ __forceinline__ void p0_transpose4(const float* __restrict__ W, int N, bf16_t* __restrict__ Wt, int kt0, int nt, float* lds) {
    const int tid = threadIdx.x;
    float v[4][8];
#pragma unroll
    for (int q = 0; q < 4; ++q)
#pragma unroll
        for (int i = 0; i < 8; ++i) {
            const int kl = (tid >> 6) + 8 * i, nl = tid & 63, n = nt * 64 + nl;
            v[q][i] = (n < N) ? W[(size_t)((kt0 + q) * 64 + kl) * N + n] : 0.f;
        }
#pragma unroll
    for (int q = 0; q < 4; ++q)
#pragma unroll
        for (int i = 0; i < 8; ++i) lds[q * 4160 + ((tid >> 6) + 8 * i) * 65 + (tid & 63)] = v[q][i];
    __syncthreads();
#pragma unroll
    for (int q = 0; q < 4; ++q) {
        const int nl = tid >> 3, kc = (tid & 7) * 8;
        const float* t = lds + q * 4160;
        uint4 o;
        o.x = pk_bf16(t[(kc + 0) * 65 + nl], t[(kc + 1) * 65 + nl]);
        o.y = pk_bf16(t[(kc + 2) * 65 + nl], t[(kc + 3) * 65 + nl]);
        o.z = pk_bf16(t[(kc + 4) * 65 + nl], t[(kc + 5) * 65 + nl]);
        o.w = pk_bf16(t[(kc + 6) * 65 + nl], t[(kc + 7) * 65 + nl]);
        *(uint4*)(Wt + (size_t)(nt * 64 + nl) * DM + (kt0 + q) * 64 + kc) = o;
    }
    __syncthreads();
}
__device__ __forceinline__ void p0_cvt(const float* __restrict__ src, bf16_t* __restrict__ dst, int item) {
    const size_t base = (size_t)item * 16384;
#pragma unroll
    for (int it = 0; it < 4; ++it) {
        const size_t idx = base + (size_t)(it * NTHR + threadIdx.x) * 8;
        const float4 a = *(const float4*)(src + idx), b = *(const float4*)(src + idx + 4);
        uint4 o; o.x = pk_bf16(a.x, a.y); o.y = pk_bf16(a.z, a.w); o.z = pk_bf16(b.x, b.y); o.w = pk_bf16(b.z, b.w);
        *(uint4*)(dst + idx) = o;
    }
}
__device__ __forceinline__ void p0_fp8rows(const float* __restrict__ src, unsigned char* __restrict__ dst, float* __restrict__ scales, int item) {
    const int w = threadIdx.x >> 6, lane = threadIdx.x & 63, row0 = item * 16 + w * 2;
    float4 v[2][8]; float am[2] = {0.f, 0.f};
#pragma unroll
    for (int q = 0; q < 2; ++q)
#pragma unroll
        for (int i = 0; i < 8; ++i) v[q][i] = *(const float4*)(src + (size_t)(row0 + q) * DM + i * 256 + lane * 4);
#pragma unroll
    for (int q = 0; q < 2; ++q) {
#pragma unroll
        for (int i = 0; i < 8; ++i) am[q] = fmaxf(am[q], fmaxf(fmaxf(fabsf(v[q][i].x), fabsf(v[q][i].y)), fmaxf(fabsf(v[q][i].z), fabsf(v[q][i].w))));
        am[q] = fmaxf(__uint_as_float(umax64(__float_as_uint(am[q]))), 1e-30f);
        const float inv = 448.f / am[q];
#pragma unroll
        for (int i = 0; i < 8; ++i) {
            int pk = __builtin_amdgcn_cvt_pk_fp8_f32(v[q][i].x * inv, v[q][i].y * inv, 0, false);
            pk = __builtin_amdgcn_cvt_pk_fp8_f32(v[q][i].z * inv, v[q][i].w * inv, pk, true);
            *(int*)(dst + (size_t)(row0 + q) * DM + i * 256 + lane * 4) = pk;
        }
        if (lane == 0) scales[row0 + q] = am[q] * (1.f / 448.f);
    }
}
__device__ __forceinline__ void p0_lora(const P& p, int item) {
    bf16_t* wl = (bf16_t*)(p.ws + OFF_WL);
#pragma unroll
    for (int j = 0; j < 8; ++j) {
        const int idx = item * 4096 + j * NTHR + threadIdx.x, n = idx & 1023, k = idx >> 10;
        const float v = k < 64 ? p.in[I_WUP][k * 1024 + n] : (k < 128 ? p.in[I_AUP][(k - 64) * 1024 + n] : p.in[I_GUP][(k - 128) * 1024 + n]);
        wl[n * 288 + k] = (bf16_t)(pk_bf16(v, 0.f) & 0xffffu);
    }
}
__device__ __forceinline__ void p0_rms(const P& p, int item) {
    const int w = threadIdx.x >> 6, lane = threadIdx.x & 63, row = item * 8 + w;
    const bool norm = row < NTOK;
    const float* src = norm ? x_row(p, row) : p.in[I_SSH] + (size_t)(row - NTOK) * DM;
    float4 v[8]; float ss = 0.f;
#pragma unroll
    for (int i = 0; i < 8; ++i) { v[i] = *(const float4*)(src + i * 256 + lane * 4); ss += v[i].x * v[i].x + v[i].y * v[i].y + v[i].z * v[i].z + v[i].w * v[i].w; }
    ss = sum64(ss);
    const float r = norm ? rsqrtf(ss * (1.f / DM) + 1e-6f) : 1.f;
    float* sh = nullptr;
    if (row < NPROMPT) { if ((row & 2047) == 2047) sh = p.out + O_SHP + (size_t)(row >> 11) * DM; }
    else if (row < NTOK) { const int s = row - NPROMPT; if ((s & 3) == 3) sh = p.out + O_SHS + (size_t)(s >> 2) * DM; }
    bf16_t* dst = (bf16_t*)(p.ws + OFF_A1) + (size_t)row * DM;
#pragma unroll
    for (int i = 0; i < 8; ++i) {
        float4 g = norm ? *(const float4*)(p.in[I_N1G] + i * 256 + lane * 4) : make_float4(1.f, 1.f, 1.f, 1.f);
        float4 y = make_float4(v[i].x * r * g.x, v[i].y * r * g.y, v[i].z * r * g.z, v[i].w * r * g.w);
        uint2 o; o.x = pk_bf16(y.x, y.y); o.y = pk_bf16(y.z, y.w);
        *(uint2*)(dst + i * 256 + lane * 4) = o;
        if (sh) *(float4*)(sh + i * 256 + lane * 4) = y;
    }
}
__device__ __forceinline__ void phase0(const P& p, unsigned char* lds) {
    constexpr int N_RMS = NROW1 / 8, N_TWIN = 88 * 8, N_TW = 32 * 8, N_SK = 2;
    constexpr int E0 = N_RMS, E1 = E0 + N_TWIN, E2 = E1 + N_TW, E3 = E2 + N_TW, E4 = E3 + N_SK, E7 = E4 + 72;
    for (int it = blockIdx.x; it < E7; it += gridDim.x) {
        if (it < E0) p0_rms(p, it);
        else if (it < E1) { const int j = it - E0; p0_transpose4(p.in[I_WIN], 5408, (bf16_t*)(p.ws + OFF_WIN), (j & 7) * 4, j >> 3, (float*)lds); }
        else if (it < E2) { const int j = it - E1; p0_transpose4(p.in[I_WOUT], 2048, (bf16_t*)(p.ws + OFF_WOUT), (j & 7) * 4, j >> 3, (float*)lds); }
        else if (it < E3) { const int j = it - E2; p0_transpose4(p.in[I_WQ], 2048, (bf16_t*)(p.ws + OFF_WQ), (j & 7) * 4, j >> 3, (float*)lds); }
        else if (it < E4) p0_cvt(p.in[I_SUBK], (bf16_t*)(p.ws + OFF_SK), it - E3);
        else p0_lora(p, it - E4);
    }
}

constexpr int G_STAGE = (128 + 256) * 144;
template <class Epi>
__device__ __forceinline__ void gemm_tile(const bf16_t* __restrict__ A, const bf16_t* __restrict__ Bt, int m0, int n0, unsigned char* lds, const Epi& epi) {
    const int tid = threadIdx.x, lane = tid & 63, w = tid >> 6, wm = w >> 2, wn = w & 3, r = lane & 31, hh = lane >> 5;
    u32x4 s0a0, s0a1, s0b0, s0b1, s0b2, s0b3, s1a0, s1a1, s1b0, s1b1, s1b2, s1b3;
    const bf16_t* ga[2]; const bf16_t* gb[4]; int la[2], lb[4];
#pragma unroll
    for (int i = 0; i < 2; ++i) { const int c = tid + i * NTHR, row = c >> 3, kc = c & 7; ga[i] = A + (size_t)(m0 + row) * DM + kc * 8; la[i] = row * 144 + kc * 16; }
#pragma unroll
    for (int i = 0; i < 4; ++i) { const int c = tid + i * NTHR, row = c >> 3, kc = c & 7; gb[i] = Bt + (size_t)(n0 + row) * DM + kc * 8; lb[i] = 128 * 144 + row * 144 + kc * 16; }
    f32x16 acc[2][2];
#pragma unroll
    for (int a = 0; a < 2; ++a)
#pragma unroll
        for (int b = 0; b < 2; ++b)
#pragma unroll
            for (int e = 0; e < 16; ++e) acc[a][b][e] = 0.f;
#define G_LOAD(S, KT)                                                                       \
    {                                                                                       \
        S##a0 = *(const u32x4*)(ga[0] + (KT) * 64); S##a1 = *(const u32x4*)(ga[1] + (KT) * 64); \
        S##b0 = *(const u32x4*)(gb[0] + (KT) * 64); S##b1 = *(const u32x4*)(gb[1] + (KT) * 64); \
        S##b2 = *(const u32x4*)(gb[2] + (KT) * 64); S##b3 = *(const u32x4*)(gb[3] + (KT) * 64); \
    }
#define G_STORE(S, ST)                                                                      \
    {                                                                                       \
        *(u32x4*)(lds + (ST) * G_STAGE + la[0]) = S##a0; *(u32x4*)(lds + (ST) * G_STAGE + la[1]) = S##a1; \
        *(u32x4*)(lds + (ST) * G_STAGE + lb[0]) = S##b0; *(u32x4*)(lds + (ST) * G_STAGE + lb[1]) = S##b1; \
        *(u32x4*)(lds + (ST) * G_STAGE + lb[2]) = S##b2; *(u32x4*)(lds + (ST) * G_STAGE + lb[3]) = S##b3; \
    }
    const int aoff = (wm * 64 + r) * 144 + hh * 16, boff = 128 * 144 + (wn * 64 + r) * 144 + hh * 16;
#define G_COMPUTE(ST)                                                                       \
    {                                                                                       \
        const unsigned char* cur = lds + (ST) * G_STAGE;                                    \
        _Pragma("unroll") for (int ks = 0; ks < 4; ++ks) {                                  \
            bf16x8 af[2], bfv[2];                                                           \
            _Pragma("unroll") for (int mi = 0; mi < 2; ++mi) af[mi] = *(const bf16x8*)(cur + aoff + mi * 32 * 144 + ks * 32);  \
            _Pragma("unroll") for (int ni = 0; ni < 2; ++ni) bfv[ni] = *(const bf16x8*)(cur + boff + ni * 32 * 144 + ks * 32); \
            _Pragma("unroll") for (int mi = 0; mi < 2; ++mi)                                \
                _Pragma("unroll") for (int ni = 0; ni < 2; ++ni) acc[mi][ni] = __builtin_amdgcn_mfma_f32_32x32x16_bf16(bfv[ni], af[mi], acc[mi][ni], 0, 0, 0); \
        }                                                                                   \
    }
    G_LOAD(s0, 0)
    G_LOAD(s1, 1)
    G_STORE(s0, 0)
    G_LOAD(s0, 2)
    __syncthreads();
#pragma unroll 1
    for (int kt = 0; kt < 32; kt += 2) {
        G_COMPUTE(0)
        G_STORE(s1, 1)
        G_LOAD(s1, (kt + 3 < 32 ? kt + 3 : 31))
        __syncthreads();
        G_COMPUTE(1)
        G_STORE(s0, 0)
        G_LOAD(s0, (kt + 4 < 32 ? kt + 4 : 31))
        __syncthreads();
    }
#undef G_LOAD
#undef G_STORE
#undef G_COMPUTE
    float* stg = (float*)lds;
#pragma unroll
    for (int mi = 0; mi < 2; ++mi)
#pragma unroll
        for (int ni = 0; ni < 2; ++ni)
#pragma unroll
            for (int g = 0; g < 4; ++g)
                *(float4*)(stg + mi * 16640 + (wm * 32 + r) * 260 + wn * 64 + ni * 32 + 8 * g + 4 * hh) =
                    make_float4(acc[mi][ni][4 * g], acc[mi][ni][4 * g + 1], acc[mi][ni][4 * g + 2], acc[mi][ni][4 * g + 3]);
    __syncthreads();
    if (Epi::KEEP_IMAGE) return;
#pragma unroll
    for (int mi = 0; mi < 2; ++mi)
#pragma unroll
        for (int k = 0; k < 8; ++k) {
            const int idx = tid + k * NTHR, lrow = idx >> 6, c4 = (idx & 63) * 4;
            const float4 v = *(const float4*)(stg + mi * 16640 + lrow * 260 + c4);
            epi(m0 + (lrow >> 5) * 64 + mi * 32 + (lrow & 31), n0 + c4, v);
        }
    __syncthreads();
}

struct Epi1 {
    static constexpr bool KEEP_IMAGE = false;
    bf16_t* za; float* pb;
    __device__ __forceinline__ void operator()(int m, int n, float4 v) const {
        if (n < 2048) {
            if (m < NTOK) { uint2 o; o.x = pk_bf16(gelu_exact(v.x), gelu_exact(v.y)); o.y = pk_bf16(gelu_exact(v.z), gelu_exact(v.w)); *(uint2*)(za + (size_t)m * DM + n) = o; }
        } else if (n < 5408) *(float4*)(pb + (size_t)m * WBW + (n - 2048)) = v;
    }
};
struct Epi2 {
    static constexpr bool KEEP_IMAGE = false;
    const float* xp; const float* xs; float* h;
    __device__ __forceinline__ void operator()(int m, int n, float4 v) const {
        const float4 x = *(const float4*)((m < NPROMPT ? xp + (size_t)m * DM : xs + (size_t)(m - NPROMPT) * DM) + n);
        *(float4*)(h + (size_t)m * DM + n) = make_float4(x.x + v.x, x.y + v.y, x.z + v.z, x.w + v.w);
    }
};
struct Epi3 {
    static constexpr bool KEEP_IMAGE = true;
    bf16_t* q;
    __device__ __forceinline__ void operator()(int m, int n, float4 v) const { uint2 o; o.x = pk_bf16(v.x, v.y); o.y = pk_bf16(v.z, v.w); *(uint2*)(q + (size_t)m * DM + n) = o; }
};

__device__ __forceinline__ void phase2(const P& p, unsigned char* ldsb) {
    bf16_t* Xs = (bf16_t*)ldsb;
    const int tid = threadIdx.x, w = tid >> 6, lane = tid & 63, r = lane & 31, hh = lane >> 5;
    const bf16_t* za = (const bf16_t*)(p.ws + OFF_ZA);
    const float* pb = (const float*)(p.ws + OFF_PB);
    const bf16_t* wl = (const bf16_t*)(p.ws + OFF_WL);
    bf16_t* vn = (bf16_t*)(p.ws + OFF_VN);
    float* dec = (float*)(p.ws + OFF_DEC); float* aa = (float*)(p.ws + OFF_AA); float* gg = (float*)(p.ws + OFF_GG);
    for (int item = blockIdx.x; item < NTOK / 34; item += gridDim.x) {
        const int tok0 = item * 34;
#pragma unroll 1
        for (int tt = 0; tt < 5; ++tt) {
            const int tl = w + 8 * tt, tok = tok0 + tl;
            if (tl >= 34) break;
            float x[16];
#pragma unroll
            for (int hf = 0; hf < 2; ++hf) {
                const uint4 d = *(const uint4*)(za + (size_t)tok * DM + 1024 + hf * 512 + lane * 8);
                x[hf * 8 + 0] = bf_lo(d.x); x[hf * 8 + 1] = bf_hi(d.x); x[hf * 8 + 2] = bf_lo(d.y); x[hf * 8 + 3] = bf_hi(d.y);
                x[hf * 8 + 4] = bf_lo(d.z); x[hf * 8 + 5] = bf_hi(d.z); x[hf * 8 + 6] = bf_lo(d.w); x[hf * 8 + 7] = bf_hi(d.w);
            }
            const float* pr = pb + (size_t)tok * WBW + 3072;
            const float* pp = prev_row(pb, tok);
            float c0[5], c1[5];
#pragma unroll
            for (int i = 0; i < 5; ++i) { const int col = i * 64 + lane; c0[i] = col < 288 ? pr[col] : 0.f; c1[i] = (pp && col < 288) ? pp[3072 + col] : 0.f; }
            float s = 0.f;
#pragma unroll
            for (int i = 0; i < 16; ++i) s += x[i];
            const float mean = sum64(s) * (1.f / 1024.f);
            float s2 = 0.f;
#pragma unroll
            for (int i = 0; i < 16; ++i) { x[i] -= mean; s2 += x[i] * x[i]; }
            const float rstd = rsqrtf(sum64(s2) * (1.f / 1024.f) + 1e-5f);
            float* cv = nullptr;
            if (tok < NPROMPT) { const int t = tok & 2047; if (t >= 1920) cv = p.out + O_CVP + ((size_t)(tok >> 11) * 128 + (t - 1920)) * 1024; }
            else cv = p.out + O_CVS + (size_t)(tok - NPROMPT) * 1024;
#pragma unroll
            for (int hf = 0; hf < 2; ++hf) {
                const int c = hf * 512 + lane * 8;
                const float4 g0 = *(const float4*)(p.in[I_LNG] + c), g1 = *(const float4*)(p.in[I_LNG] + c + 4);
                const float4 b0 = *(const float4*)(p.in[I_LNB] + c), b1 = *(const float4*)(p.in[I_LNB] + c + 4);
                float y[8];
                y[0] = x[hf * 8 + 0] * rstd * g0.x + b0.x; y[1] = x[hf * 8 + 1] * rstd * g0.y + b0.y; y[2] = x[hf * 8 + 2] * rstd * g0.z + b0.z; y[3] = x[hf * 8 + 3] * rstd * g0.w + b0.w;
                y[4] = x[hf * 8 + 4] * rstd * g1.x + b1.x; y[5] = x[hf * 8 + 5] * rstd * g1.y + b1.y; y[6] = x[hf * 8 + 6] * rstd * g1.z + b1.z; y[7] = x[hf * 8 + 7] * rstd * g1.w + b1.w;
                uint4 o; o.x = pk_bf16(y[0], y[1]); o.y = pk_bf16(y[2], y[3]); o.z = pk_bf16(y[4], y[5]); o.w = pk_bf16(y[6], y[7]);
                *(uint4*)(vn + (size_t)tok * 1024 + c) = o;
                if (cv) { *(float4*)(cv + c) = make_float4(y[0], y[1], y[2], y[3]); *(float4*)(cv + c + 4) = make_float4(y[4], y[5], y[6], y[7]); }
            }
#pragma unroll
            for (int i = 0; i < 5; ++i) {
                const int col = i * 64 + lane;
                if (col < 288) {
                    const float q = c0[i] + (c1[i] - c0[i]) * p.in[I_MU][3072 + col];
                    const float xv = col < 64 ? tanhf(q) : (col < 128 ? q : sigmoidf_(q));
                    Xs[tl * 296 + col] = (bf16_t)(pk_bf16(xv, 0.f) & 0xffffu);
                }
            }
        }
        __syncthreads();
#pragma unroll 1
        for (int mt = 0; mt < 2; ++mt) {
        bf16x8 af[18];
#pragma unroll
        for (int ks = 0; ks < 18; ++ks) af[ks] = *(const bf16x8*)(Xs + (mt * 32 + r) * 296 + ks * 16 + hh * 8);
#pragma unroll 1
        for (int nt = 0; nt < 4; ++nt) {
            const int n = w * 128 + nt * 32 + r;
            const bf16_t* wrow = wl + (size_t)n * 288 + hh * 8;
            f32x16 aw, ac, ag;
#pragma unroll
            for (int e = 0; e < 16; ++e) { aw[e] = 0.f; ac[e] = 0.f; ag[e] = 0.f; }
#pragma unroll
            for (int ks = 0; ks < 4; ++ks) aw = __builtin_amdgcn_mfma_f32_32x32x16_bf16(af[ks], *(const bf16x8*)(wrow + ks * 16), aw, 0, 0, 0);
#pragma unroll
            for (int ks = 4; ks < 8; ++ks) ac = __builtin_amdgcn_mfma_f32_32x32x16_bf16(af[ks], *(const bf16x8*)(wrow + ks * 16), ac, 0, 0, 0);
#pragma unroll
            for (int ks = 8; ks < 18; ++ks) ag = __builtin_amdgcn_mfma_f32_32x32x16_bf16(af[ks], *(const bf16x8*)(wrow + ks * 16), ag, 0, 0, 0);
            const float w0 = p.in[I_W0][n], a0 = p.in[I_A0][n];
#pragma unroll
            for (int e = 0; e < 16; ++e) {
                const int tl = mt * 32 + (e & 3) + 8 * (e >> 2) + 4 * hh, tok = tok0 + tl;
                if (tl < 34) {
                    const float z = -(w0 + aw[e]);
                    const float sp = fmaxf(z, 0.f) + log1pf(__expf(-fabsf(z)));
                    dec[(size_t)tok * 1024 + n] = __expf(-__expf(-sp - 0.5f));
                    aa[(size_t)tok * 1024 + n] = sigmoidf_(a0 + ac[e]);
                    gg[(size_t)tok * 1024 + n] = ag[e];
                }
            }
        }
        }
        __syncthreads();
    }
}

struct StepV { float4 a0, a1, q0, q1, w0, w1, b0, b1, k0, k1; float v, br, kr; };
__device__ __forceinline__ void step_load(StepV& s, const float* lds, int tl, int j0, int row) {
    const float* b = lds + tl * 64 + j0;
    s.a0 = *(const float4*)(b); s.a1 = *(const float4*)(b + 4);
    s.q0 = *(const float4*)(b + 4096); s.q1 = *(const float4*)(b + 4096 + 4);
    s.w0 = *(const float4*)(b + 8192); s.w1 = *(const float4*)(b + 8192 + 4);
    s.b0 = *(const float4*)(b + 12288); s.b1 = *(const float4*)(b + 12288 + 4);
    s.k0 = *(const float4*)(b + 16384); s.k1 = *(const float4*)(b + 16384 + 4);
    s.v = lds[20480 + tl * 64 + row]; s.br = lds[32768 + tl]; s.kr = lds[32768 + 64 + tl];
}
__device__ __forceinline__ float step_compute(f32x2 (&S)[4], const StepV& s) {
    f32x2 t1 = S[0] * (f32x2){s.a0.x, s.a0.y} + S[1] * (f32x2){s.a0.z, s.a0.w} + S[2] * (f32x2){s.a1.x, s.a1.y} + S[3] * (f32x2){s.a1.z, s.a1.w};
    f32x2 t2 = S[0] * (f32x2){s.q0.x, s.q0.y} + S[1] * (f32x2){s.q0.z, s.q0.w} + S[2] * (f32x2){s.q1.x, s.q1.y} + S[3] * (f32x2){s.q1.z, s.q1.w};
    float sa = t1.x + t1.y, sy = t2.x + t2.y;
    sa += dppf<0xB1>(sa); sy += dppf<0xB1>(sy);
    sa += dppf<0x4E>(sa); sy += dppf<0x4E>(sy);
    sa += dppf<0x141>(sa); sy += dppf<0x141>(sy);
    S[0] = S[0] * (f32x2){s.w0.x, s.w0.y} + sa * (f32x2){s.b0.x, s.b0.y} + s.v * (f32x2){s.k0.x, s.k0.y};
    S[1] = S[1] * (f32x2){s.w0.z, s.w0.w} + sa * (f32x2){s.b0.z, s.b0.w} + s.v * (f32x2){s.k0.z, s.k0.w};
    S[2] = S[2] * (f32x2){s.w1.x, s.w1.y} + sa * (f32x2){s.b1.x, s.b1.y} + s.v * (f32x2){s.k1.x, s.k1.y};
    S[3] = S[3] * (f32x2){s.w1.z, s.w1.w} + sa * (f32x2){s.b1.z, s.b1.w} + s.v * (f32x2){s.k1.z, s.k1.w};
    return sy + sa * s.br + s.v * s.kr;
}
__device__ __forceinline__ void scan_item(const P& p, int tokbase, int T, int h, const float* s0, float* sout, float* lds) {
    const int tid = threadIdx.x, w = tid >> 6, lane = tid & 63, row = tid >> 3, seg = tid & 7, j0 = seg * 8;
    const float* pb = (const float*)(p.ws + OFF_PB);
    const float* dec = (const float*)(p.ws + OFF_DEC); const float* aa = (const float*)(p.ws + OFF_AA); const float* gg = (const float*)(p.ws + OFF_GG);
    bf16_t* a2 = (bf16_t*)(p.ws + OFF_A2);
    const int col = h * 64 + lane;
    const float mu_r = p.in[I_MU][col], mu_k = p.in[I_MU][1024 + col], mu_v = p.in[I_MU][2048 + col];
    const float kkw = p.in[I_KK][col], kaw = p.in[I_KA][col], rkw = p.in[I_RK][col], gng = p.in[I_GNG][col], gnb = p.in[I_GNB][col];
    f32x2 S[4];
    if (s0) {
        const float4 a = *(const float4*)(s0 + row * 64 + j0), b = *(const float4*)(s0 + row * 64 + j0 + 4);
        S[0] = (f32x2){a.x, a.y}; S[1] = (f32x2){a.z, a.w}; S[2] = (f32x2){b.x, b.y}; S[3] = (f32x2){b.z, b.w};
    } else { S[0] = S[1] = S[2] = S[3] = (f32x2){0.f, 0.f}; }
    float prw[9][3], pd[8], pa[8], pg[8];
#define PRE_LOAD(T0)                                                                                                   \
    if ((T0) + 8 * w < T) {                                                                                            \
        const int tokf = tokbase + (T0) + 8 * w;                                                                       \
        const float* pp = prev_row(pb, tokf);                                                                          \
        prw[0][0] = pp ? pp[col] : 0.f; prw[0][1] = pp ? pp[1024 + col] : 0.f; prw[0][2] = pp ? pp[2048 + col] : 0.f;  \
        _Pragma("unroll") for (int i = 0; i < 8; ++i) {                                                                \
            if ((T0) + 8 * w + i < T) {                                                                                \
                const float* pr = pb + (size_t)(tokf + i) * WBW;                                                       \
                prw[i + 1][0] = pr[col]; prw[i + 1][1] = pr[1024 + col]; prw[i + 1][2] = pr[2048 + col];               \
                pd[i] = dec[(size_t)(tokf + i) * 1024 + col]; pa[i] = aa[(size_t)(tokf + i) * 1024 + col]; pg[i] = gg[(size_t)(tokf + i) * 1024 + col]; \
            }                                                                                                          \
        }                                                                                                              \
    }
    PRE_LOAD(0)
    for (int t0 = 0; t0 < T; t0 += 64) {
        const int n = (T - t0) < 64 ? (T - t0) : 64;
#pragma unroll
        for (int i = 0; i < 8; ++i) {
            const int tl = 8 * w + i;
            if (tl < n) {
                const float r = prw[i + 1][0] + (prw[i][0] - prw[i + 1][0]) * mu_r, k = prw[i + 1][1] + (prw[i][1] - prw[i + 1][1]) * mu_k, v = prw[i + 1][2] + (prw[i][2] - prw[i + 1][2]) * mu_v;
                const float d = pd[i], a = pa[i];
                float kk = k * kkw;
                const float ssq = sum64(kk * kk);
                kk *= rsqrtf(fmaxf(ssq, 1e-24f));
                const float km = k * (1.f + (a - 1.f) * kaw);
                const float bb = kk * a;
                const float bon = sum64(r * km * rkw), br = sum64(bb * r), kr = sum64(km * r);
                lds[tl * 64 + lane] = -kk; lds[4096 + tl * 64 + lane] = d * r; lds[8192 + tl * 64 + lane] = d; lds[12288 + tl * 64 + lane] = bb;
                lds[16384 + tl * 64 + lane] = km; lds[20480 + tl * 64 + lane] = v; lds[24576 + tl * 64 + lane] = pg[i];
                if (lane == 0) { lds[32768 + tl] = br; lds[32832 + tl] = kr; lds[32896 + tl] = bon; }
            }
            __builtin_amdgcn_sched_barrier(0);
        }
        __syncthreads();
        if (t0 + 64 < T) { PRE_LOAD(t0 + 64) }
        {
            const float* bq = lds + j0;
            float4 a0 = *(const float4*)(bq), a1 = *(const float4*)(bq + 4), q0 = *(const float4*)(bq + 4096), q1 = *(const float4*)(bq + 4100);
#pragma unroll 1
            for (int tl = 0; tl < n; ++tl) {
                const float* b = bq + tl * 64;
                const float4 w0 = *(const float4*)(b + 8192), w1 = *(const float4*)(b + 8196), b0 = *(const float4*)(b + 12288), b1 = *(const float4*)(b + 12292);
                const float4 k0 = *(const float4*)(b + 16384), k1 = *(const float4*)(b + 16388);
                const float v = lds[20480 + tl * 64 + row], br = lds[32768 + tl], kr = lds[32832 + tl];
                const int tn = (tl + 1 < n) ? tl + 1 : tl;
                const float4 na0 = *(const float4*)(bq + tn * 64), na1 = *(const float4*)(bq + tn * 64 + 4), nq0 = *(const float4*)(bq + tn * 64 + 4096), nq1 = *(const float4*)(bq + tn * 64 + 4100);
                f32x2 t1 = S[0] * (f32x2){a0.x, a0.y} + S[1] * (f32x2){a0.z, a0.w} + S[2] * (f32x2){a1.x, a1.y} + S[3] * (f32x2){a1.z, a1.w};
                f32x2 t2 = S[0] * (f32x2){q0.x, q0.y} + S[1] * (f32x2){q0.z, q0.w} + S[2] * (f32x2){q1.x, q1.y} + S[3] * (f32x2){q1.z, q1.w};
                float sa = t1.x + t1.y, sy = t2.x + t2.y;
                sa += dppf<0xB1>(sa); sy += dppf<0xB1>(sy);
                sa += dppf<0x4E>(sa); sy += dppf<0x4E>(sy);
                sa += dppf<0x141>(sa); sy += dppf<0x141>(sy);
                S[0] = S[0] * (f32x2){w0.x, w0.y} + sa * (f32x2){b0.x, b0.y} + v * (f32x2){k0.x, k0.y};
                S[1] = S[1] * (f32x2){w0.z, w0.w} + sa * (f32x2){b0.z, b0.w} + v * (f32x2){k0.z, k0.w};
                S[2] = S[2] * (f32x2){w1.x, w1.y} + sa * (f32x2){b1.x, b1.y} + v * (f32x2){k1.x, k1.y};
                S[3] = S[3] * (f32x2){w1.z, w1.w} + sa * (f32x2){b1.z, b1.w} + v * (f32x2){k1.z, k1.w};
                if (seg == 0) lds[28672 + tl * 64 + row] = sy + sa * br + v * kr;
                a0 = na0; a1 = na1; q0 = nq0; q1 = nq1;
            }
        }
        __syncthreads();
#pragma unroll
        for (int i = 0; i < 8; ++i) {
            const int tl = w + 8 * i;
            if (tl < n) {
                const int tok = tokbase + t0 + tl;
                const float y = lds[28672 + tl * 64 + lane];
                const float mean = sum64(y) * (1.f / 64.f);
                const float yc = y - mean;
                const float var = sum64(yc * yc) * (1.f / 64.f);
                const float yn = yc * rsqrtf(var + 6.4e-4f) * gng + gnb;
                const float o = (yn + lds[32896 + tl] * lds[20480 + tl * 64 + lane]) * lds[24576 + tl * 64 + lane];
                a2[(size_t)tok * DM + 1024 + col] = (bf16_t)(pk_bf16(o, 0.f) & 0xffffu);
            }
            __builtin_amdgcn_sched_barrier(0);
        }
        __syncthreads();
    }
#undef PRE_LOAD
    *(float4*)(sout + row * 64 + j0) = make_float4(S[0].x, S[0].y, S[1].x, S[1].y);
    *(float4*)(sout + row * 64 + j0 + 4) = make_float4(S[2].x, S[2].y, S[3].x, S[3].y);
}

__device__ __forceinline__ void scan_prompt_q(const P& p, int b, int h, int rq, float* lds) {
    const int tid = threadIdx.x, w = tid >> 6, lane = tid & 63, row = (tid >> 4) & 15, seg = tid & 15, j0 = seg * 4;
    const float* pb = (const float*)(p.ws + OFF_PB);
    const float* dec = (const float*)(p.ws + OFF_DEC); const float* aa = (const float*)(p.ws + OFF_AA);
    float* yraw = (float*)(p.ws + OFF_YRAW); bf16_t* bonv = (bf16_t*)(p.ws + OFF_BONV);
    const int col = h * 64 + lane, tokbase = b * 2048;
    const float mu_r = p.in[I_MU][col], mu_k = p.in[I_MU][1024 + col], mu_v = p.in[I_MU][2048 + col];
    const float kkw = p.in[I_KK][col], kaw = p.in[I_KA][col], rkw = p.in[I_RK][col];
    f32x2 S[2]; S[0] = S[1] = (f32x2){0.f, 0.f};
    const bool prod = w >= 4; const int pw = w & 3;
#define DERIVE_CHUNK(C)                                                                                                \
    {                                                                                                                  \
        float* bufp = lds + ((C) & 1) * 12416;                                                                         \
        float prw[9][3], pd[8], pa[8];                                                                                 \
        const int tokf = tokbase + (C) * 32 + 8 * pw;                                                                  \
        const float* pp = prev_row(pb, tokf);                                                                          \
        prw[0][0] = pp ? pp[col] : 0.f; prw[0][1] = pp ? pp[1024 + col] : 0.f; prw[0][2] = pp ? pp[2048 + col] : 0.f;  \
        _Pragma("unroll") for (int i = 0; i < 8; ++i) {                                                                \
            const float* pr = pb + (size_t)(tokf + i) * WBW;                                                           \
            prw[i + 1][0] = pr[col]; prw[i + 1][1] = pr[1024 + col]; prw[i + 1][2] = pr[2048 + col];                   \
            pd[i] = dec[(size_t)(tokf + i) * 1024 + col]; pa[i] = aa[(size_t)(tokf + i) * 1024 + col];                 \
        }                                                                                                              \
        _Pragma("unroll") for (int i = 0; i < 8; ++i) {                                                                \
            const int tl = 8 * pw + i;                                                                                 \
            const float r = prw[i + 1][0] + (prw[i][0] - prw[i + 1][0]) * mu_r, k = prw[i + 1][1] + (prw[i][1] - prw[i + 1][1]) * mu_k, v = prw[i + 1][2] + (prw[i][2] - prw[i + 1][2]) * mu_v; \
            const float d = pd[i], a = pa[i];                                                                          \
            float kk = k * kkw;                                                                                        \
            const float ssq = sum64(kk * kk);                                                                          \
            kk *= rsqrtf(fmaxf(ssq, 1e-24f));                                                                          \
            const float km = k * (1.f + (a - 1.f) * kaw);                                                              \
            const float bb = kk * a;                                                                                   \
            const float bon = sum64(r * km * rkw), br = sum64(bb * r), kr = sum64(km * r);                             \
            bufp[tl * 64 + lane] = -kk; bufp[2048 + tl * 64 + lane] = d * r; bufp[4096 + tl * 64 + lane] = d; bufp[6144 + tl * 64 + lane] = bb; \
            bufp[8192 + tl * 64 + lane] = km; bufp[10240 + tl * 64 + lane] = v;                                        \
            if (lane == 0) { *(float2*)(bufp + 12288 + 2 * tl) = make_float2(br, kr); }                                           \
            if (rq == 0) bonv[(size_t)(tokf + i) * 1024 + col] = (bf16_t)(pk_bf16(bon * v, 0.f) & 0xffffu);            \
            __builtin_amdgcn_sched_barrier(0);                                                                         \
        }                                                                                                              \
    }
#define FLUSH_Y(C)                                                                                                     \
    {                                                                                                                  \
        const int pt = tid & 255, t = pt >> 3, r2 = (pt & 7) * 2;                                                      \
        const float4 pa_ = *(const float4*)(lds + 24832 + ((C) & 1) * 2048 + t * 64 + r2 * 4), pb_ = *(const float4*)(lds + 24832 + ((C) & 1) * 2048 + t * 64 + r2 * 4 + 4); \
        *(float2*)(yraw + (size_t)(tokbase + (C) * 32 + t) * 1024 + h * 64 + rq * 16 + r2) = make_float2((pa_.x + pa_.y) + (pa_.z + pa_.w), (pb_.x + pb_.y) + (pb_.z + pb_.w)); \
    }
    if (prod) { DERIVE_CHUNK(0) }
    __syncthreads();
#pragma unroll 1
    for (int c = 0; c < 64; ++c) {
        if (!prod) {
            const float* bq = lds + (c & 1) * 12416 + j0;
            float* sy_out = lds + 24832 + (c & 1) * 2048;
            float4 a = *(const float4*)(bq), q = *(const float4*)(bq + 2048), wv = *(const float4*)(bq + 4096), bv = *(const float4*)(bq + 6144), kv = *(const float4*)(bq + 8192);
            float v = bq[10240 - j0 + rq * 16 + row]; float2 bk = *(const float2*)(bq + 12288 - j0);
#pragma unroll 2
            for (int tl = 0; tl < 32; ++tl) {
                const int tn = (tl + 1 < 32) ? tl + 1 : tl;
                const float* bp = bq + tn * 64;
                const float4 na = *(const float4*)(bp), nq = *(const float4*)(bp + 2048), nw = *(const float4*)(bp + 4096), nb = *(const float4*)(bp + 6144), nk = *(const float4*)(bp + 8192);
                float nv = bq[10240 - j0 + tn * 64 + rq * 16 + row]; float2 nbk = *(const float2*)(bq + 12288 - j0 + 2 * tn);
                asm volatile("" : "+v"(nv), "+v"(nbk.x), "+v"(nbk.y));
                const f32x2 t1 = S[0] * (f32x2){a.x, a.y} + S[1] * (f32x2){a.z, a.w};
                const f32x2 t2 = S[0] * (f32x2){q.x, q.y} + S[1] * (f32x2){q.z, q.w};
                float sa = t1.x + t1.y, sy = t2.x + t2.y;
                sa += dppf<0xB1>(sa); sy += dppf<0xB1>(sy);
                sa += dppf<0x4E>(sa); sy += dppf<0x4E>(sy);
                sa += dppf<0x141>(sa);
                sa += dppf<0x140>(sa);
                S[0] = S[0] * (f32x2){wv.x, wv.y} + sa * (f32x2){bv.x, bv.y} + v * (f32x2){kv.x, kv.y};
                S[1] = S[1] * (f32x2){wv.z, wv.w} + sa * (f32x2){bv.z, bv.w} + v * (f32x2){kv.z, kv.w};
                sy_out[tl * 64 + row * 4 + (seg >> 2)] = seg < 4 ? sy + sa * bk.x + v * bk.y : sy;
                a = na; q = nq; wv = nw; bv = nb; kv = nk; v = nv; bk = nbk;
            }
        } else {
            if (c > 0) FLUSH_Y(c - 1)
            if (c + 1 < 64) { DERIVE_CHUNK(c + 1) }
        }
        __syncthreads();
    }
    if (prod) FLUSH_Y(63)
    __syncthreads();
#undef DERIVE_CHUNK
#undef FLUSH_Y
    if (w < 4) *(float4*)(p.out + O_WKVP + (size_t)(b * 16 + h) * 4096 + (rq * 16 + row) * 64 + j0) = make_float4(S[0].x, S[0].y, S[1].x, S[1].y);
}
__device__ __forceinline__ void phase3b(const P& p) {
    const int w = threadIdx.x >> 6, lane = threadIdx.x & 63;
    const float* yraw = (const float*)(p.ws + OFF_YRAW); const bf16_t* bonv = (const bf16_t*)(p.ws + OFF_BONV); const float* gg = (const float*)(p.ws + OFF_GG);
    bf16_t* a2 = (bf16_t*)(p.ws + OFF_A2);
    float gng[16], gnb[16];
#pragma unroll
    for (int q = 0; q < 16; ++q) { gng[q] = p.in[I_GNG][q * 64 + lane]; gnb[q] = p.in[I_GNB][q * 64 + lane]; }
    for (int tok = w * (int)gridDim.x + (int)blockIdx.x; tok < NPROMPT; tok += 8 * (int)gridDim.x) {
        float y[16], bv[16], g[16];
#pragma unroll
        for (int q = 0; q < 16; ++q) {
            const size_t off = (size_t)tok * 1024 + q * 64 + lane;
            y[q] = yraw[off]; bv[q] = bf1(bonv[off]); g[q] = gg[off];
        }
#pragma unroll
        for (int q = 0; q < 16; ++q) {
            const float mean = sum64(y[q]) * (1.f / 64.f);
            const float yc = y[q] - mean;
            const float var = sum64(yc * yc) * (1.f / 64.f);
            const float yn = yc * rsqrtf(var + 6.4e-4f) * gng[q] + gnb[q];
            const float o = (yn + bv[q]) * g[q];
            a2[(size_t)tok * DM + 1024 + q * 64 + lane] = (bf16_t)(pk_bf16(o, 0.f) & 0xffffu);
        }
    }
}

__device__ __forceinline__ void scan_sample_wave(const P& p, int j, float* wl) {
    const int lane = threadIdx.x & 63, b = j >> 4, h = j & 15, col = h * 64 + lane, tokb = NPROMPT + b * 4;
    const float* pb = (const float*)(p.ws + OFF_PB);
    const float* dec = (const float*)(p.ws + OFF_DEC); const float* aa = (const float*)(p.ws + OFF_AA); const float* gg = (const float*)(p.ws + OFF_GG);
    bf16_t* a2 = (bf16_t*)(p.ws + OFF_A2);
    const float* s0 = p.in[I_SWKV] + (size_t)j * 4096 + lane * 64;
    float4 S[16];
#pragma unroll
    for (int i = 0; i < 16; ++i) S[i] = *(const float4*)(s0 + i * 4);
    float prw[5][3], pd[4], pa[4], gv[4];
    {
        const float* pp = pb + (size_t)(NTOK + b) * WBW;
        prw[0][0] = pp[col]; prw[0][1] = pp[1024 + col]; prw[0][2] = pp[2048 + col];
#pragma unroll
        for (int t = 0; t < 4; ++t) {
            const float* pr = pb + (size_t)(tokb + t) * WBW;
            prw[t + 1][0] = pr[col]; prw[t + 1][1] = pr[1024 + col]; prw[t + 1][2] = pr[2048 + col];
            pd[t] = dec[(size_t)(tokb + t) * 1024 + col]; pa[t] = aa[(size_t)(tokb + t) * 1024 + col]; gv[t] = gg[(size_t)(tokb + t) * 1024 + col];
        }
    }
    const float mu_r = p.in[I_MU][col], mu_k = p.in[I_MU][1024 + col], mu_v = p.in[I_MU][2048 + col];
    const float kkw = p.in[I_KK][col], kaw = p.in[I_KA][col], rkw = p.in[I_RK][col], gng = p.in[I_GNG][col], gnb = p.in[I_GNB][col];
    float vv[4], bon[4], brv[4], krv[4];
#pragma unroll
    for (int t = 0; t < 4; ++t) {
        const float r = prw[t + 1][0] + (prw[t][0] - prw[t + 1][0]) * mu_r, k = prw[t + 1][1] + (prw[t][1] - prw[t + 1][1]) * mu_k, v = prw[t + 1][2] + (prw[t][2] - prw[t + 1][2]) * mu_v;
        const float d = pd[t], a = pa[t];
        float kk = k * kkw;
        kk *= rsqrtf(fmaxf(sum64(kk * kk), 1e-24f));
        const float km = k * (1.f + (a - 1.f) * kaw), bb = kk * a;
        bon[t] = sum64(r * km * rkw); brv[t] = sum64(bb * r); krv[t] = sum64(km * r); vv[t] = v;
        wl[(t * 5 + 0) * 64 + lane] = -kk; wl[(t * 5 + 1) * 64 + lane] = d * r; wl[(t * 5 + 2) * 64 + lane] = d; wl[(t * 5 + 3) * 64 + lane] = bb; wl[(t * 5 + 4) * 64 + lane] = km;
    }
    __builtin_amdgcn_wave_barrier();
#pragma unroll 1
    for (int t = 0; t < 4; ++t) {
        const float* va = wl + (t * 5) * 64;
        float sa = 0.f, sy = 0.f;
#pragma unroll
        for (int i = 0; i < 16; ++i) {
            const float4 a4 = *(const float4*)(va + i * 4), q4 = *(const float4*)(va + 64 + i * 4);
            sa += S[i].x * a4.x + S[i].y * a4.y + S[i].z * a4.z + S[i].w * a4.w;
            sy += S[i].x * q4.x + S[i].y * q4.y + S[i].z * q4.z + S[i].w * q4.w;
        }
        const float v = t == 0 ? vv[0] : (t == 1 ? vv[1] : (t == 2 ? vv[2] : vv[3]));
        const float br = t == 0 ? brv[0] : (t == 1 ? brv[1] : (t == 2 ? brv[2] : brv[3]));
        const float kr = t == 0 ? krv[0] : (t == 1 ? krv[1] : (t == 2 ? krv[2] : krv[3]));
        const float bo = t == 0 ? bon[0] : (t == 1 ? bon[1] : (t == 2 ? bon[2] : bon[3]));
        const float g = t == 0 ? gv[0] : (t == 1 ? gv[1] : (t == 2 ? gv[2] : gv[3]));
        const float y = sy + sa * br + v * kr;
#pragma unroll
        for (int i = 0; i < 16; ++i) {
            const float4 w4 = *(const float4*)(va + 128 + i * 4), b4 = *(const float4*)(va + 192 + i * 4), k4 = *(const float4*)(va + 256 + i * 4);
            S[i].x = S[i].x * w4.x + sa * b4.x + v * k4.x; S[i].y = S[i].y * w4.y + sa * b4.y + v * k4.y;
            S[i].z = S[i].z * w4.z + sa * b4.z + v * k4.z; S[i].w = S[i].w * w4.w + sa * b4.w + v * k4.w;
        }
        const float mean = sum64(y) * (1.f / 64.f);
        const float yc = y - mean;
        const float var = sum64(yc * yc) * (1.f / 64.f);
        const float yn = yc * rsqrtf(var + 6.4e-4f) * gng + gnb;
        const float o = (yn + bo * v) * g;
        a2[(size_t)(tokb + t) * DM + 1024 + col] = (bf16_t)(pk_bf16(o, 0.f) & 0xffffu);
    }
    float* so = p.out + O_WKVS + (size_t)j * 4096 + lane * 64;
#pragma unroll
    for (int i = 0; i < 16; ++i) *(float4*)(so + i * 4) = S[i];
    __builtin_amdgcn_wave_barrier();
}

__device__ __forceinline__ void gate_item(const P& p, int b, int c, int h, unsigned char* lds) {
    bf16_t* As = (bf16_t*)lds; bf16_t* Bs = (bf16_t*)(lds + 128 * 272);
    const int tid = threadIdx.x, lane = tid & 63, w = tid >> 6, wm = w >> 2, wn = w & 3, r = lane & 31, hh = lane >> 5;
    const bf16_t* vn = (const bf16_t*)(p.ws + OFF_VN); const bf16_t* za = (const bf16_t*)(p.ws + OFF_ZA); bf16_t* a2 = (bf16_t*)(p.ws + OFF_A2);
    const int tokb = b * 2048 + c * 128;
    const float* wsh = p.in[I_WS] + (size_t)h * 16384;
#pragma unroll
    for (int i = 0; i < 8; ++i) {
        const int idx = tid + i * NTHR, t = idx >> 5, s4 = (idx & 31) * 4;
        float4 v = *(const float4*)(wsh + t * 128 + s4);
        if (s4 + 0 > t) v.x = 0.f; if (s4 + 1 > t) v.y = 0.f; if (s4 + 2 > t) v.z = 0.f; if (s4 + 3 > t) v.w = 0.f;
        uint2 o; o.x = pk_bf16(v.x, v.y); o.y = pk_bf16(v.z, v.w);
        *(uint2*)(As + t * 136 + s4) = o;
    }
#pragma unroll
    for (int i = 0; i < 4; ++i) {
        const int ch = tid + i * NTHR, s = ch >> 4, d8 = (ch & 15) * 8;
        const uint4 d = *(const uint4*)(vn + (size_t)(tokb + s) * 1024 + h * 128 + d8);
        Bs[(d8 + 0) * 136 + s] = (bf16_t)(d.x & 0xffff); Bs[(d8 + 1) * 136 + s] = (bf16_t)(d.x >> 16);
        Bs[(d8 + 2) * 136 + s] = (bf16_t)(d.y & 0xffff); Bs[(d8 + 3) * 136 + s] = (bf16_t)(d.y >> 16);
        Bs[(d8 + 4) * 136 + s] = (bf16_t)(d.z & 0xffff); Bs[(d8 + 5) * 136 + s] = (bf16_t)(d.z >> 16);
        Bs[(d8 + 6) * 136 + s] = (bf16_t)(d.w & 0xffff); Bs[(d8 + 7) * 136 + s] = (bf16_t)(d.w >> 16);
    }
    __syncthreads();
    f32x16 acc[2];
#pragma unroll
    for (int a = 0; a < 2; ++a)
#pragma unroll
        for (int e = 0; e < 16; ++e) acc[a][e] = 0.f;
#pragma unroll
    for (int ks = 0; ks < 8; ++ks) {
        const bf16x8 bfv = *(const bf16x8*)(Bs + (wn * 32 + r) * 136 + ks * 16 + hh * 8);
#pragma unroll
        for (int mi = 0; mi < 2; ++mi) {
            const bf16x8 af = *(const bf16x8*)(As + (wm * 64 + mi * 32 + r) * 136 + ks * 16 + hh * 8);
            acc[mi] = __builtin_amdgcn_mfma_f32_32x32x16_bf16(af, bfv, acc[mi], 0, 0, 0);
        }
    }
    const int d = wn * 32 + r, colc = h * 128 + d;
#pragma unroll
    for (int mi = 0; mi < 2; ++mi)
#pragma unroll
        for (int e = 0; e < 16; ++e) {
            const int t = wm * 64 + mi * 32 + (e & 3) + 8 * (e >> 2) + 4 * hh, tok = tokb + t;
            const float mixed = acc[mi][e] + p.in[I_BS][h * 128 + t];
            const float u = bf1(za[(size_t)tok * DM + colc]);
            a2[(size_t)tok * DM + colc] = (bf16_t)(pk_bf16(u * mixed, 0.f) & 0xffffu);
        }
    __syncthreads();
}
__device__ __forceinline__ void gate_sample_item(const P& p, int b) {
    const bf16_t* vn = (const bf16_t*)(p.ws + OFF_VN); const bf16_t* za = (const bf16_t*)(p.ws + OFF_ZA); bf16_t* a2 = (bf16_t*)(p.ws + OFF_A2);
    const int c = 2 * threadIdx.x, h = c >> 7, tokb = NPROMPT + b * 4;
    float v0[4], v1[4];
#pragma unroll
    for (int s = 0; s < 4; ++s) { const unsigned d = *(const unsigned*)(vn + (size_t)(tokb + s) * 1024 + c); v0[s] = bf_lo(d); v1[s] = bf_hi(d); }
#pragma unroll
    for (int t = 0; t < 4; ++t) {
        float m0 = p.in[I_BS][h * 128 + t], m1 = m0;
#pragma unroll
        for (int s = 0; s <= t; ++s) { const float wv = p.in[I_WS][(size_t)h * 16384 + t * 128 + s]; m0 += wv * v0[s]; m1 += wv * v1[s]; }
        const unsigned u = *(const unsigned*)(za + (size_t)(tokb + t) * DM + c);
        *(unsigned*)(a2 + (size_t)(tokb + t) * DM + c) = pk_bf16(bf_lo(u) * m0, bf_hi(u) * m1);
    }
}
__device__ __forceinline__ void phase3(const P& p, unsigned char* lds) {
    const int G = gridDim.x, bid = blockIdx.x;
    for (int it = bid; it < 256; it += G) scan_prompt_q(p, it >> 6, (it >> 2) & 15, it & 3, (float*)lds);
    for (int j = bid * 8 + (threadIdx.x >> 6); j < 2048; j += G * 8) scan_sample_wave(p, j, (float*)lds + (threadIdx.x >> 6) * 1280);
    __syncthreads();
    constexpr int N_G = 512, N_GS = 128;
    for (int it = bid; it < N_G + N_GS; it += G) {
        if (it < N_G) gate_item(p, it >> 7, (it >> 3) & 15, it & 7, lds);
        else gate_sample_item(p, it - N_G);
    }
}

__device__ __forceinline__ void phase5(const P& p) {
    const int w = threadIdx.x >> 6, lane = threadIdx.x & 63;
    const float* H = (const float*)(p.ws + OFF_H); bf16_t* a3 = (bf16_t*)(p.ws + OFF_A3);
    unsigned char* xq = p.ws + OFF_XQ; float* sx = (float*)(p.ws + OFF_SX);
    for (int row = w * (int)gridDim.x + (int)blockIdx.x; row < NTOK; row += 8 * (int)gridDim.x) {
        const float* src = H + (size_t)row * DM;
        float4 v[8]; float ss = 0.f;
#pragma unroll
        for (int i = 0; i < 8; ++i) { v[i] = *(const float4*)(src + i * 256 + lane * 4); ss += v[i].x * v[i].x + v[i].y * v[i].y + v[i].z * v[i].z + v[i].w * v[i].w; }
        ss = sum64(ss);
        const float r = rsqrtf(ss * (1.f / DM) + 1e-6f);
        float am = 0.f;
#pragma unroll
        for (int i = 0; i < 8; ++i) {
            const float4 g = *(const float4*)(p.in[I_N2G] + i * 256 + lane * 4);
            v[i] = make_float4(v[i].x * r * g.x, v[i].y * r * g.y, v[i].z * r * g.z, v[i].w * r * g.w);
            uint2 o; o.x = pk_bf16(v[i].x, v[i].y); o.y = pk_bf16(v[i].z, v[i].w);
            *(uint2*)(a3 + (size_t)row * DM + i * 256 + lane * 4) = o;
            am = fmaxf(am, fmaxf(fmaxf(fabsf(v[i].x), fabsf(v[i].y)), fmaxf(fabsf(v[i].z), fabsf(v[i].w))));
        }
        am = fmaxf(__uint_as_float(umax64(__float_as_uint(am))), 1e-30f);
        const float inv = 448.f / am;
#pragma unroll
        for (int i = 0; i < 8; ++i) {
            int pk = __builtin_amdgcn_cvt_pk_fp8_f32(v[i].x * inv, v[i].y * inv, 0, false);
            pk = __builtin_amdgcn_cvt_pk_fp8_f32(v[i].z * inv, v[i].w * inv, pk, true);
            *(int*)(xq + (size_t)row * DM + i * 256 + lane * 4) = pk;
        }
        if (lane == 0) sx[row] = am * (1.f / 448.f);
    }
}

#define TOP16_INSERT(T, X)                                                                  \
    {                                                                                       \
        unsigned x_ = (X);                                                                  \
        _Pragma("unroll") for (int i_ = 0; i_ < 16; ++i_) { const unsigned hi_ = T[i_] > x_ ? T[i_] : x_; x_ = T[i_] > x_ ? x_ : T[i_]; T[i_] = hi_; } \
    }
__device__ __forceinline__ void topk_item(const P& p, int item, unsigned char* lds) {
    float* Sc0 = (float*)lds; float* Sc1 = (float*)(lds + 66048);
    float* tS = (float*)(lds + 132096); unsigned char* tI = lds + 132096 + 17408;
    const int tid = threadIdx.x, lane = tid & 63, w = tid >> 6, wm = w >> 2, wn = w & 3, r = lane & 31, hh = lane >> 5;
    const bf16_t* skb = (const bf16_t*)(p.ws + OFF_SK);
    int* eidx = (int*)(p.ws + OFF_EIDX); float* gate = (float*)(p.ws + OFF_GATE);
    {
        const int tb = item >> 3, h = item & 7, tok0 = tb * 128;
        const float* stg = (const float*)lds;
        f32x16 acc[2][2];
#pragma unroll
        for (int c = 0; c < 2; ++c) {
#pragma unroll
            for (int a = 0; a < 2; ++a)
#pragma unroll
                for (int e2 = 0; e2 < 16; ++e2) acc[c][a][e2] = 0.f;
            const bf16_t* kb = skb + (size_t)(c * 128 + wn * 32 + r) * 128 + hh * 8;
#pragma unroll
            for (int ks = 0; ks < 8; ++ks) {
                const bf16x8 bfv = *(const bf16x8*)(kb + ks * 16);
#pragma unroll
                for (int mi = 0; mi < 2; ++mi) {
                    const float* ap = stg + mi * 16640 + (wm * 32 + r) * 260 + c * 128 + ks * 16 + hh * 8;
                    const float4 f0 = *(const float4*)(ap), f1 = *(const float4*)(ap + 4);
                    const unsigned u0 = pk_bf16(f0.x, f0.y), u1 = pk_bf16(f0.z, f0.w), u2 = pk_bf16(f1.x, f1.y), u3 = pk_bf16(f1.z, f1.w);
                    const u32x4 uf = {u0, u1, u2, u3};
                    const bf16x8 af = __builtin_bit_cast(bf16x8, uf);
                    acc[c][mi] = __builtin_amdgcn_mfma_f32_32x32x16_bf16(af, bfv, acc[c][mi], 0, 0, 0);
                }
            }
        }
        __syncthreads();
#pragma unroll
        for (int c = 0; c < 2; ++c) {
            float* Sc = c ? Sc1 : Sc0;
#pragma unroll
            for (int mi = 0; mi < 2; ++mi)
#pragma unroll
                for (int e2 = 0; e2 < 16; ++e2) Sc[(wm * 64 + mi * 32 + (e2 & 3) + 8 * (e2 >> 2) + 4 * hh) * 129 + wn * 32 + r] = acc[c][mi][e2];
        }
        __syncthreads();
        if (w < 4) {
            const int c = w >> 1, row = (w & 1) * 64 + lane;
            const float* Sr = (c ? Sc1 : Sc0) + row * 129;
            unsigned t[16];
#pragma unroll
            for (int i = 0; i < 16; ++i) t[i] = 0u;
#pragma unroll 4
            for (int j = 0; j < 128; ++j) { const unsigned x = (ord_key(Sr[j]) & ~127u) | (unsigned)(127 - j); TOP16_INSERT(t, x) }
#pragma unroll
            for (int i = 0; i < 16; ++i) {
                const int idx = 127 - (int)(t[i] & 127u);
                tS[(c * 128 + row) * 17 + i] = Sr[idx]; tI[(c * 128 + row) * 16 + i] = (unsigned char)idx;
            }
        }
        __syncthreads();
        if (w < 2) {
            const int row = w * 64 + lane, tok = tok0 + row;
            float a[16], b[16];
#pragma unroll
            for (int i = 0; i < 16; ++i) { a[i] = tS[row * 17 + i]; b[i] = tS[(128 + row) * 17 + i]; }
            unsigned t[16];
#pragma unroll
            for (int i = 0; i < 16; ++i) t[i] = 0u;
#pragma unroll
            for (int i = 0; i < 16; ++i)
#pragma unroll
                for (int j = 0; j < 16 / (i + 1); ++j) { const unsigned x = (ord_key(a[i] + b[j]) & ~255u) | (unsigned)(255 - (i * 16 + j)); TOP16_INSERT(t, x) }
            float val[16]; int ex[16]; float se = 0.f;
#pragma unroll
            for (int k = 0; k < 16; ++k) {
                const int code = 255 - (int)(t[k] & 255u), ci = code >> 4, cj = code & 15;
                val[k] = tS[row * 17 + ci] + tS[(128 + row) * 17 + cj];
                ex[k] = (int)tI[row * 16 + ci] * 128 + (int)tI[(128 + row) * 16 + cj];
            }
            const float mx = val[0];
#pragma unroll
            for (int k = 0; k < 16; ++k) val[k] = __expf(val[k] - mx);
#pragma unroll
            for (int k = 0; k < 16; ++k) se += val[k];
            const float inv = 1.f / se;
            int4* ep = (int4*)(eidx + (size_t)tok * 128 + h * 16); float4* gp = (float4*)(gate + (size_t)tok * 128 + h * 16);
#pragma unroll
            for (int q = 0; q < 4; ++q) {
                ep[q] = make_int4(ex[4 * q], ex[4 * q + 1], ex[4 * q + 2], ex[4 * q + 3]);
                gp[q] = make_float4(val[4 * q] * inv, val[4 * q + 1] * inv, val[4 * q + 2] * inv, val[4 * q + 3] * inv);
            }
        }
        __syncthreads();
    }
}

__device__ __forceinline__ void phase8(const P& p, unsigned char* lds) {
    const int tid = threadIdx.x, lane = tid & 63, w = tid >> 6, r = lane & 15, g = lane >> 4;
    unsigned char* xs = lds + w * 2048;
    int* eb = (int*)(lds + 16384) + w * 128; float* gbuf = (float*)(lds + 20480) + w * 128; float* cb = (float*)(lds + 24576) + w * 128;
    const unsigned char* Uq = p.ws + OFF_UB; const unsigned char* Vq = p.ws + OFF_VB;
    const float* su = (const float*)(p.ws + OFF_SU); const float* sv = (const float*)(p.ws + OFF_SV);
    const unsigned char* xq = p.ws + OFF_XQ; const float* sx = (const float*)(p.ws + OFF_SX);
    const float* H = (const float*)(p.ws + OFF_H);
    const int* eidx = (const int*)(p.ws + OFF_EIDX); const float* gate = (const float*)(p.ws + OFF_GATE);
    const int G = gridDim.x, n_main = NTOK / (8 * G), n_tail_tok = NTOK - n_main * 8 * G, n_tail_it = (n_tail_tok + 2 * G - 1) / (2 * G);
    float* part = (float*)(lds + 32768) + w * 2048;
#pragma unroll 1
    for (int it = 0; it < n_main + n_tail_it; ++it) {
        const bool split = it >= n_main;
        int tok, g_lo, g_hi;
        if (!split) { tok = w * G + (int)blockIdx.x + it * 8 * G; g_lo = 0; g_hi = 8; }
        else { const int tt = (it - n_main) * 2 * G + (w >> 2) * G + (int)blockIdx.x; tok = tt < n_tail_tok ? n_main * 8 * G + tt : NTOK; g_lo = 2 * (w & 3); g_hi = g_lo + 2; }
        const bool active = tok < NTOK;
        float o[32];
#pragma unroll
        for (int i = 0; i < 32; ++i) o[i] = 0.f;
        if (active) {
        *(uint4*)(xs + lane * 32) = *(const uint4*)(xq + (size_t)tok * DM + lane * 32);
        *(uint4*)(xs + lane * 32 + 16) = *(const uint4*)(xq + (size_t)tok * DM + lane * 32 + 16);
        eb[lane] = eidx[(size_t)tok * 128 + lane]; eb[64 + lane] = eidx[(size_t)tok * 128 + 64 + lane];
        gbuf[lane] = gate[(size_t)tok * 128 + lane]; gbuf[64 + lane] = gate[(size_t)tok * 128 + 64 + lane];
        const float sxt = sx[tok];
        __builtin_amdgcn_wave_barrier();
#pragma unroll 1
        for (int grp = g_lo; grp < g_hi; ++grp) {
            const int e = eb[grp * 16 + r];
            const uint4* row = (const uint4*)(Uq + (size_t)e * DM + g * 32);
            f32x4 acc = {0.f, 0.f, 0.f, 0.f};
            uint4 A[32];
#pragma unroll
            for (int kk = 0; kk < 16; ++kk) { A[2 * kk] = row[kk * 8]; A[2 * kk + 1] = row[kk * 8 + 1]; }
#pragma unroll
            for (int kk = 0; kk < 16; ++kk) {
                const uint4 b0 = *(const uint4*)(xs + kk * 128 + g * 32), b1 = *(const uint4*)(xs + kk * 128 + g * 32 + 16);
                const i32x8 av = {(int)A[2 * kk].x, (int)A[2 * kk].y, (int)A[2 * kk].z, (int)A[2 * kk].w, (int)A[2 * kk + 1].x, (int)A[2 * kk + 1].y, (int)A[2 * kk + 1].z, (int)A[2 * kk + 1].w};
                const i32x8 bv = {(int)b0.x, (int)b0.y, (int)b0.z, (int)b0.w, (int)b1.x, (int)b1.y, (int)b1.z, (int)b1.w};
                acc = __builtin_amdgcn_mfma_scale_f32_16x16x128_f8f6f4(av, bv, acc, 0, 0, 0, 0, 0, 0);
            }
            if (r == 0) {
#pragma unroll
                for (int q = 0; q < 4; ++q) {
                    const int idx = grp * 16 + 4 * g + q, ee = eb[idx];
                    const float d = acc[q] * su[ee] * sxt;
                    cb[idx] = gbuf[idx] * gelu_exact(d) * sv[ee];
                }
            }
        }
        __builtin_amdgcn_wave_barrier();
#define VACC(D, I, C)                                                                                                   \
    {                                                                                                                  \
        f32x2 t;                                                                                                       \
        t = __builtin_amdgcn_cvt_pk_f32_fp8((int)(D).x, false); o[(I) * 16 + 0] += (C) * t.x; o[(I) * 16 + 1] += (C) * t.y;   \
        t = __builtin_amdgcn_cvt_pk_f32_fp8((int)(D).x, true);  o[(I) * 16 + 2] += (C) * t.x; o[(I) * 16 + 3] += (C) * t.y;   \
        t = __builtin_amdgcn_cvt_pk_f32_fp8((int)(D).y, false); o[(I) * 16 + 4] += (C) * t.x; o[(I) * 16 + 5] += (C) * t.y;   \
        t = __builtin_amdgcn_cvt_pk_f32_fp8((int)(D).y, true);  o[(I) * 16 + 6] += (C) * t.x; o[(I) * 16 + 7] += (C) * t.y;   \
        t = __builtin_amdgcn_cvt_pk_f32_fp8((int)(D).z, false); o[(I) * 16 + 8] += (C) * t.x; o[(I) * 16 + 9] += (C) * t.y;   \
        t = __builtin_amdgcn_cvt_pk_f32_fp8((int)(D).z, true);  o[(I) * 16 + 10] += (C) * t.x; o[(I) * 16 + 11] += (C) * t.y; \
        t = __builtin_amdgcn_cvt_pk_f32_fp8((int)(D).w, false); o[(I) * 16 + 12] += (C) * t.x; o[(I) * 16 + 13] += (C) * t.y; \
        t = __builtin_amdgcn_cvt_pk_f32_fp8((int)(D).w, true);  o[(I) * 16 + 14] += (C) * t.x; o[(I) * 16 + 15] += (C) * t.y; \
    }
#pragma unroll 1
        for (int e8 = g_lo * 16; e8 < g_hi * 16; e8 += 8) {
            uint4 d0[8], d1[8];
#pragma unroll
            for (int q = 0; q < 8; ++q) {
                const uint4* row = (const uint4*)(Vq + (size_t)eb[e8 + q] * DM) + lane;
                d0[q] = row[0]; d1[q] = row[64];
            }
#pragma unroll
            for (int q = 0; q < 8; ++q) {
                const float c = cb[e8 + q];
                asm volatile("" : "+v"(d0[q].x), "+v"(d0[q].y), "+v"(d0[q].z), "+v"(d0[q].w), "+v"(d1[q].x), "+v"(d1[q].y), "+v"(d1[q].z), "+v"(d1[q].w), "+v"(o[0]), "+v"(o[16]));
                VACC(d0[q], 0, c)
                VACC(d1[q], 1, c)
            }
        }
#undef VACC
        }
        bool fin = active && !split;
        if (split) {
            if (active) {
#pragma unroll
                for (int i = 0; i < 32; ++i) part[i * 64 + lane] = o[i];
            }
            __syncthreads();
            fin = active && (w & 3) == 0;
            if (fin) {
#pragma unroll
                for (int i = 0; i < 32; ++i) o[i] += part[2048 + i * 64 + lane] + part[4096 + i * 64 + lane] + part[6144 + i * 64 + lane];
            }
            __syncthreads();
        }
        if (fin) {
        float ss = 0.f;
#pragma unroll
        for (int i = 0; i < 2; ++i)
#pragma unroll
            for (int k = 0; k < 4; ++k) {
                const float4 hv = *(const float4*)(H + (size_t)tok * DM + i * 1024 + lane * 16 + k * 4);
                o[i * 16 + k * 4 + 0] += hv.x; o[i * 16 + k * 4 + 1] += hv.y; o[i * 16 + k * 4 + 2] += hv.z; o[i * 16 + k * 4 + 3] += hv.w;
#pragma unroll
                for (int e = 0; e < 4; ++e) ss += o[i * 16 + k * 4 + e] * o[i * 16 + k * 4 + e];
            }
        ss = sum64(ss);
        const float rs = rsqrtf(ss * (1.f / DM) + 1e-6f);
        float* y = p.out + O_Y + (size_t)tok * DM;
#pragma unroll
        for (int i = 0; i < 2; ++i)
#pragma unroll
            for (int k = 0; k < 4; ++k) {
                const float4 gv = *(const float4*)(p.in[I_FG] + i * 1024 + lane * 16 + k * 4);
                *(float4*)(y + i * 1024 + lane * 16 + k * 4) = make_float4(o[i * 16 + k * 4 + 0] * rs * gv.x, o[i * 16 + k * 4 + 1] * rs * gv.y, o[i * 16 + k * 4 + 2] * rs * gv.z, o[i * 16 + k * 4 + 3] * rs * gv.w);
            }
        }
        __builtin_amdgcn_wave_barrier();
    }
}

__device__ __forceinline__ void fp8_table_filler(const float* src, unsigned char* dst, float* scales) {
    const int G = gridDim.x, nb = (68 * 8) % G;
    if (nb == 0) { for (int it = blockIdx.x; it < 1024; it += G) p0_fp8rows(src, dst, scales, it); }
    else if ((int)blockIdx.x >= nb) { for (int it = blockIdx.x - nb; it < 1024; it += G - nb) p0_fp8rows(src, dst, scales, it); }
}

#ifndef ONLY_PHASE
#define ONLY_PHASE -1
#endif
#ifndef DBL_PHASE
#define DBL_PHASE -1
#endif
#ifndef DBG_AFTER
#define DBG_AFTER 99
#endif
#ifndef DBG_WHAT
#define DBG_WHAT 0
#endif
__device__ __forceinline__ void dbg_dump(const P& p) {
    const size_t n = (size_t)NTOK * DM;
    for (size_t i = (size_t)blockIdx.x * NTHR + threadIdx.x; i < n; i += (size_t)gridDim.x * NTHR) {
        float v = 0.f;
        if (DBG_WHAT == 0) v = bf1(((const bf16_t*)(p.ws + OFF_A2))[i]);
        else if (DBG_WHAT == 1) v = bf1(((const bf16_t*)(p.ws + OFF_ZA))[i]);
        else if (DBG_WHAT == 2) v = ((const float*)(p.ws + OFF_PB))[i];
        else if (DBG_WHAT == 3) v = ((const float*)(p.ws + OFF_PB))[i + 11000000];
        else if (DBG_WHAT == 4) v = ((const float*)(p.ws + OFF_DEC))[i];
        else if (DBG_WHAT == 5) v = ((const float*)(p.ws + OFF_GG))[i & 8388607] + ((const float*)(p.ws + OFF_AA))[i & 8388607];
        else if (DBG_WHAT == 6) v = ((const float*)(p.ws + OFF_H))[i];
        else if (DBG_WHAT == 7) v = bf1(((const bf16_t*)(p.ws + OFF_QB))[i]);
        else if (DBG_WHAT == 8) v = (i < (size_t)NTOK * 128) ? (float)((const int*)(p.ws + OFF_EIDX))[i] : ((i < (size_t)NTOK * 256) ? ((const float*)(p.ws + OFF_GATE))[i - (size_t)NTOK * 128] : 0.f);
        else if (DBG_WHAT == 10) v = bf1(((const bf16_t*)(p.ws + OFF_A3))[i]);
        else if (DBG_WHAT == 9) v = bf1(((const bf16_t*)(p.ws + OFF_VN))[i >> 1]);
        p.out[i] = v;
    }
}
typedef const __attribute__((address_space(4))) P* cP4;
__device__ __forceinline__ P load_params() {
#if defined(__HIP_DEVICE_COMPILE__)
    unsigned long long ka = (unsigned long long)__builtin_amdgcn_kernarg_segment_ptr();
    asm volatile("" : "+s"(ka));
    P r;
#pragma unroll
    for (int i = 0; i < 28; ++i) r.in[i] = ((cP4)ka)->in[i];
    r.out = ((cP4)ka)->out; r.ws = ((cP4)ka)->ws;
    return r;
#else
    return P{};
#endif
}
#define PHASE_BEGIN(n) if ((n) == DBG_AFTER + 1 && ph_lo <= (n) && (n) <= ph_hi) { const P p = load_params(); dbg_dump(p); } if ((ONLY_PHASE < 0 || (n) == ONLY_PHASE) && (n) <= DBG_AFTER && ph_lo <= (n) && (n) <= ph_hi) { const P p = load_params(); for (int rep_ = 0; rep_ < ((n) == DBL_PHASE ? 2 : 1); ++rep_) { if (rep_) xcd_barrier(xb_);
#define PHASE_END(n) } } if (ph_lo <= (n) && (n) < ph_hi) xcd_barrier(xb_); asm volatile("" ::: "memory");
__global__ void __launch_bounds__(NTHR) mega(P p_arg, int ph_lo, int ph_hi) {
    __shared__ __attribute__((aligned(16))) unsigned char lds[LDS_BYTES];
    __shared__ uint4 xb_words;
    if (threadIdx.x == 0) xb_words = make_uint4(0u, 0u, 0u, 0u);
    __syncthreads();
    const XcdBarrier xb_ = xcd_barrier_post((unsigned*)(load_params().ws + OFF_BAR), (volatile LAS unsigned*)&xb_words);
    if (ph_lo > ph_hi) cg::this_grid().sync();
    PHASE_BEGIN(0) phase0(p, lds); PHASE_END(0)
    PHASE_BEGIN(1) { Epi1 e{(bf16_t*)(p.ws + OFF_ZA), (float*)(p.ws + OFF_PB)};
        const int G = gridDim.x, GR = (69 * 22 + G - 1) / G * G;
        for (int L = blockIdx.x; L < GR; L += G) {
            int id = L;
            if ((G & 7) == 0) { const int rnd = L / G, inr = L % G; id = rnd * G + (inr & 7) * (G >> 3) + (inr >> 3); }
            if (id >= 69 * 22) continue;
            const int g8 = id / (8 * 22), fm = g8 * 8, gsz = (69 - fm) < 8 ? (69 - fm) : 8, rem = id - g8 * (8 * 22);
            gemm_tile((const bf16_t*)(p.ws + OFF_A1), (const bf16_t*)(p.ws + OFF_WIN), (fm + rem % gsz) * 128, (rem / gsz) * 256, lds, e);
        } } PHASE_END(1)
    PHASE_BEGIN(2) phase2(p, lds); PHASE_END(2)
    PHASE_BEGIN(3) phase3(p, lds); PHASE_END(3)
    PHASE_BEGIN(4) phase3b(p); PHASE_END(4)
    PHASE_BEGIN(5) { Epi2 e{p.in[I_XP], p.in[I_XS], (float*)(p.ws + OFF_H)};
        for (int t = blockIdx.x; t < 68 * 8; t += gridDim.x) gemm_tile((const bf16_t*)(p.ws + OFF_A2), (const bf16_t*)(p.ws + OFF_WOUT), (t >> 3) * 128, (t & 7) * 256, lds, e);
        fp8_table_filler(p.in[I_UT], p.ws + OFF_UB, (float*)(p.ws + OFF_SU)); } PHASE_END(5)
    PHASE_BEGIN(6) phase5(p); PHASE_END(6)
    PHASE_BEGIN(7) { Epi3 e{(bf16_t*)(p.ws + OFF_QB)};
        for (int t = blockIdx.x; t < 68 * 8; t += gridDim.x) {
            gemm_tile((const bf16_t*)(p.ws + OFF_A3), (const bf16_t*)(p.ws + OFF_WQ), (t >> 3) * 128, (t & 7) * 256, lds, e);
            topk_item(p, t, lds);
        }
        fp8_table_filler(p.in[I_VT], p.ws + OFF_VB, (float*)(p.ws + OFF_SV)); } PHASE_END(7)
    PHASE_BEGIN(8) phase8(p, lds); PHASE_END(8)
}

extern "C" void kernel_launch(void* const* d_in, const int* in_sizes, int n_in, void* d_out, int out_size, void* d_ws, size_t ws_size, hipStream_t stream) {
    static int grid = 0;
    if (grid == 0) {
        if (n_in != 28 || ws_size < WS_END) { fprintf(stderr, "kernel_launch: need 28 inputs and %zu bytes of workspace (got %d, %zu)\n", (size_t)WS_END, n_in, ws_size); grid = -1; return; }
        int dev = 0, cus = 0, per_cu = 0;
        hipGetDevice(&dev);
        hipDeviceGetAttribute(&cus, hipDeviceAttributeMultiprocessorCount, dev);
        hipOccupancyMaxActiveBlocksPerMultiprocessor(&per_cu, (const void*)mega, NTHR, 0);
        if (per_cu < 1) per_cu = 1;
        grid = cus * per_cu;
        if (grid < 128) { fprintf(stderr, "kernel_launch: grid %d too small\n", grid); grid = -1; return; }
    }
    if (grid < 0) return;
    P p{};
    for (int i = 0; i < 28; ++i) p.in[i] = (const float*)d_in[i];
    p.out = (float*)d_out; p.ws = (unsigned char*)d_ws;
#if ONE_LAUNCH
    hipMemsetAsync((unsigned char*)d_ws + OFF_BAR, 0, 16384, stream);
    int lo = 0, hi = (DBG_AFTER < N_PHASES - 1) ? DBG_AFTER + 1 : N_PHASES - 1;
    void* args[] = {&p, &lo, &hi};
    hipError_t e = hipLaunchCooperativeKernel((const void*)mega, dim3(grid), dim3(NTHR), args, 0, stream);
    if (e != hipSuccess) fprintf(stderr, "cooperative launch failed: %s (grid %d)\n", hipGetErrorString(e), grid);
#else
    for (int ph = 0; ph < N_PHASES; ++ph) hipLaunchKernelGGL(mega, dim3(grid), dim3(NTHR), 0, stream, p, ph, ph);
#endif
}
```
